# Optimizing an MI355X kernel written in HIP

```python
import math
import jax, jax.numpy as jnp
from jax import lax
import numpy as np

D_MODEL = 2048
BATCH = 1
SEQ = 8192
DEPTH = 4
DEC_BATCH = 1
DEC_SEQ = 16384
PAST_LEN = 128

HEAD_DIM = 128
N_GROUPS_A = 8
N_HEADS_B = 8
WIDTH_A = N_GROUPS_A * HEAD_DIM
WIDTH_B = N_HEADS_B * HEAD_DIM
MIX_WIDTH = WIDTH_A + WIDTH_B
PROJ_WIDTH = 2 * WIDTH_A + 3 * WIDTH_B
CHUNK = 128
DILATED_PATTERNS = ((128, 1), (512, 4), (2048, 16))
ROT_DIM = HEAD_DIM // 4
ROPE_THETA = 500000.0
D_FF = ((8 * D_MODEL + 3 * 256 - 1) // (3 * 256)) * 256
EPS = 1e-6
NEG_INF = -1e30

kernel_name = 'hybrid_gmlp_dilated_attn_encoder'


def rms_norm(x, gain):
    x32 = x.astype(jnp.float32)
    y = x32 * lax.rsqrt(jnp.mean(x32 * x32, axis=-1, keepdims=True) + EPS)
    return (y * gain.astype(jnp.float32)).astype(x.dtype)


def partial_rope(x):
    S = x.shape[1]
    half = ROT_DIM // 2
    inv_freq = ROPE_THETA ** (-jnp.arange(half, dtype=jnp.float32) / half)
    ang = jnp.arange(S, dtype=jnp.float32)[:, None] * inv_freq[None, :]
    cos = jnp.cos(ang)[None, :, None, :]
    sin = jnp.sin(ang)[None, :, None, :]
    xr = x[..., :ROT_DIM].astype(jnp.float32)
    x1, x2 = xr[..., :half], xr[..., half:]
    rot = jnp.concatenate([x1 * cos - x2 * sin, x2 * cos + x1 * sin], axis=-1)
    return jnp.concatenate([rot.astype(x.dtype), x[..., ROT_DIM:]], axis=-1)


def chunked_spatial_gating(u, v, v_gain, ws, bias):
    B, S, _ = u.shape
    u = jax.nn.gelu(u.astype(jnp.float32))
    v = jax.nn.gelu(v.astype(jnp.float32)).reshape(B, S // CHUNK, CHUNK, N_GROUPS_A, HEAD_DIM)
    mu = jnp.mean(v, axis=-1, keepdims=True)
    var = jnp.mean(jnp.square(v - mu), axis=-1, keepdims=True)
    v = (v - mu) * lax.rsqrt(var + EPS) * v_gain.astype(jnp.float32).reshape(N_GROUPS_A, HEAD_DIM)
    mixed = jnp.einsum('gts,bnsgc->bntgc', ws.astype(jnp.float32), v) + bias.astype(jnp.float32).T[:, :, None]
    return (u * mixed.reshape(B, S, WIDTH_A)).astype(v_gain.dtype)


def dilated_window_attention(q, k, v, window, dilation):
    B, S, H, Dh = q.shape
    R = window // (2 * dilation)
    L = S // dilation
    pad = (-L) % R
    Lp = L + pad
    nb = Lp // R

    def to_sub(t):
        return t.reshape(B, L, dilation, H, Dh).astype(jnp.float32)

    qs = jnp.pad(to_sub(q), ((0, 0), (0, pad), (0, 0), (0, 0), (0, 0)))
    ks = jnp.pad(to_sub(k), ((0, 0), (R, pad + R), (0, 0), (0, 0), (0, 0)))
    vs = jnp.pad(to_sub(v), ((0, 0), (R, pad + R), (0, 0), (0, 0), (0, 0)))
    qb = qs.reshape(B, nb, R, dilation, H, Dh)

    def neighbours(t):
        tb = t.reshape(B, nb + 2, R, dilation, H, Dh)
        return jnp.concatenate([tb[:, :-2], tb[:, 1:-1], tb[:, 2:]], axis=2)

    kb = neighbours(ks)
    vb = neighbours(vs)
    scores = jnp.einsum('bnqrhd,bnkrhd->bnrhqk', qb, kb) * (Dh ** -0.5)
    qi = jnp.arange(nb)[:, None] * R + jnp.arange(R)[None, :]
    kj = jnp.arange(nb)[:, None] * R - R + jnp.arange(3 * R)[None, :]
    valid = (jnp.abs(qi[:, :, None] - kj[:, None, :]) <= R) & (kj[:, None, :] >= 0) & (kj[:, None, :] < L)
    scores = jnp.where(valid[None, :, None, None], scores, NEG_INF)
    m = jnp.max(scores, axis=-1, keepdims=True)
    p = jnp.exp(scores - m)
    l = jnp.sum(p, axis=-1)
    o = jnp.einsum('bnrhqk,bnkrhd->bnqrhd', p, vb)
    l_t = l.transpose(0, 1, 4, 2, 3)
    o = o / l_t[..., None]
    lse = m[..., 0].transpose(0, 1, 4, 2, 3) + jnp.log(l_t)
    o = o.reshape(B, Lp, dilation, H, Dh)[:, :L].reshape(B, S, H, Dh)
    lse = lse.reshape(B, Lp, dilation, H)[:, :L].reshape(B, S, H)
    return o, lse


def dilated_mixture_attention(q, k, v):
    outs = []
    lses = []
    for window, dilation in DILATED_PATTERNS:
        o, lse = dilated_window_attention(q, k, v, window, dilation)
        outs.append(o)
        lses.append(lse)
    w = jax.nn.softmax(jnp.stack(lses, axis=0), axis=0)
    return jnp.sum(w[..., None] * jnp.stack(outs, axis=0), axis=0)


def encoder_layer(x, g_mix_pre, w_in, gmlp_v_gain, gmlp_ws, gmlp_bias, out_gain_a, out_gain_b,
                  w_o, g_mix_post, g_ffn_pre, w_gate, w_up, w_down, g_ffn_post):
    B, S, _ = x.shape
    h = rms_norm(x, g_mix_pre)
    proj = h @ w_in
    u, va, q, k, vv = jnp.split(proj, [WIDTH_A, 2 * WIDTH_A, 2 * WIDTH_A + WIDTH_B, 2 * WIDTH_A + 2 * WIDTH_B], axis=-1)
    a_out = chunked_spatial_gating(u, va, gmlp_v_gain, gmlp_ws, gmlp_bias)
    q = partial_rope(q.reshape(B, S, N_HEADS_B, HEAD_DIM))
    k = partial_rope(k.reshape(B, S, N_HEADS_B, HEAD_DIM))
    vv = vv.reshape(B, S, N_HEADS_B, HEAD_DIM)
    b_out = dilated_mixture_attention(q, k, vv).reshape(B, S, WIDTH_B).astype(x.dtype)
    merged = jnp.concatenate([rms_norm(a_out, out_gain_a), rms_norm(b_out, out_gain_b)], axis=-1)
    x = x + rms_norm(merged @ w_o, g_mix_post)
    h = rms_norm(x, g_ffn_pre)
    f = (jax.nn.silu(h @ w_gate) * (h @ w_up)) @ w_down
    return x + rms_norm(f, g_ffn_post)


def trunk(x, g_mix_pre, w_in, gmlp_v_gain, gmlp_ws, gmlp_bias, out_gain_a, out_gain_b,
          w_o, g_mix_post, g_ffn_pre, w_gate, w_up, w_down, g_ffn_post):
    for l in range(DEPTH):
        x = encoder_layer(x, g_mix_pre[l], w_in[l], gmlp_v_gain[l], gmlp_ws[l], gmlp_bias[l],
                          out_gain_a[l], out_gain_b[l], w_o[l], g_mix_post[l], g_ffn_pre[l],
                          w_gate[l], w_up[l], w_down[l], g_ffn_post[l])
    return x


def setup_inputs(seed: int = 0) -> dict:
    key = jax.random.key(seed)
    ks = jax.random.split(key, 20)
    f32 = jnp.float32

    def nrm(k, shape, scale):
        return jax.random.normal(k, shape, f32) * scale

    def gain(k, shape):
        return 1.0 + 0.05 * jax.random.normal(k, shape, f32)

    return {
        'x_prompt': jax.random.normal(ks[0], (BATCH, SEQ, D_MODEL), f32),
        'x_sample': jax.random.normal(ks[1], (DEC_BATCH, DEC_SEQ, D_MODEL), f32),
        'g_mix_pre': gain(ks[2], (DEPTH, D_MODEL)),
        'w_in': nrm(ks[3], (DEPTH, D_MODEL, PROJ_WIDTH), D_MODEL ** -0.5),
        'gmlp_v_gain': gain(ks[4], (DEPTH, WIDTH_A)),
        'gmlp_ws': nrm(ks[5], (DEPTH, N_GROUPS_A, CHUNK, CHUNK), CHUNK ** -0.5),
        'gmlp_bias': nrm(ks[6], (DEPTH, N_GROUPS_A, CHUNK), 0.02),
        'out_gain_a': gain(ks[7], (DEPTH, WIDTH_A)),
        'out_gain_b': gain(ks[8], (DEPTH, WIDTH_B)),
        'w_o': nrm(ks[9], (DEPTH, MIX_WIDTH, D_MODEL), MIX_WIDTH ** -0.5),
        'g_mix_post': gain(ks[10], (DEPTH, D_MODEL)),
        'g_ffn_pre': gain(ks[11], (DEPTH, D_MODEL)),
        'w_gate': nrm(ks[12], (DEPTH, D_MODEL, D_FF), D_MODEL ** -0.5),
        'w_up': nrm(ks[13], (DEPTH, D_MODEL, D_FF), D_MODEL ** -0.5),
        'w_down': nrm(ks[14], (DEPTH, D_FF, D_MODEL), D_FF ** -0.5),
        'g_ffn_post': gain(ks[15], (DEPTH, D_MODEL)),
    }


def reference(x_prompt, x_sample, g_mix_pre, w_in, gmlp_v_gain, gmlp_ws, gmlp_bias, out_gain_a, out_gain_b,
              w_o, g_mix_post, g_ffn_pre, w_gate, w_up, w_down, g_ffn_post):
    y_prompt = trunk(x_prompt, g_mix_pre, w_in, gmlp_v_gain, gmlp_ws, gmlp_bias, out_gain_a, out_gain_b,
                     w_o, g_mix_post, g_ffn_pre, w_gate, w_up, w_down, g_ffn_post)
    y_sample = trunk(x_sample, g_mix_pre, w_in, gmlp_v_gain, gmlp_ws, gmlp_bias, out_gain_a, out_gain_b,
                     w_o, g_mix_post, g_ffn_pre, w_gate, w_up, w_down, g_ffn_post)
    return (y_prompt, y_sample)
```

```cpp
#include <hip/hip_runtime.h>
#include <hip/hip_cooperative_groups.h>
#include <cstdio>
#include <cstdint>
namespace cg = cooperative_groups;
#ifndef REP_GEMM
#define REP_GEMM 1
#endif
#ifndef REP_MIX
#define REP_MIX 1
#endif
#ifndef REP_ATT
#define REP_ATT 1
#endif
#ifndef REP_PRO
#define REP_PRO 1
#endif
__device__ __forceinline__ int fresh_lane() { int l; asm volatile("v_mbcnt_lo_u32_b32 %0, -1, 0\n\tv_mbcnt_hi_u32_b32 %0, -1, %0" : "=v"(l)); return l; }
__device__ __forceinline__ int fresh_tid(int wave_s) { return wave_s * 64 + fresh_lane(); }
namespace pg8 {
#define PG8_LAS __attribute__((address_space(3)))
typedef unsigned short bf16_t;
typedef short bf16x8 __attribute__((ext_vector_type(8)));
typedef float f32x4 __attribute__((ext_vector_type(4)));
typedef unsigned u32x4 __attribute__((ext_vector_type(4)));
constexpr int BM = 256, BK = 64, HALF = 128, HTB = HALF * BK * 2  , STAGE_BYTES = 8 * HTB, NXCD = 8, WGM = 8;

__host__ __device__ __forceinline__ int lds_byte(int r, int c) { const int st = (r >> 4) * 2 + (c >> 5), rr = r & 15, cc = c & 31, ob = rr * 64 + cc * 2; return st * 1024 + (ob ^ (((ob >> 9) & 1) << 5)); }
__host__ __device__ __forceinline__ void stage_rc(int b, int& R, int& C) { const int st = b / 1024, sb = b % 1024, swz = sb ^ (((sb >> 9) & 1) << 5); R = (st >> 1) * 16 + swz / 64; C = (st & 1) * 32 + (swz % 64) / 2; }
__host__ __device__ __forceinline__ int perm32(int rho) { const int n = rho >> 4, i = rho & 15; return 8 * (i >> 2) + 4 * n + (i & 3); }

struct Unit { int pm, pn; };
struct Gemm { const bf16_t* A; const bf16_t* Bt; int M, N, K; };

struct StaticOrder {
    int nM, nN, nwg, G, c;
    __host__ __device__ void init(int M, int N, int G_, int c_) { nM = M / BM; nN = N / BM; nwg = nM * nN; G = G_; c = c_; }
    __host__ __device__ bool next(int i, Unit& u) const {
        const long L = (long)i * G + c; if (L >= nwg) return false;
        int wgid = (int)L; { const int q = nwg / NXCD, r = nwg % NXCD, xcd = wgid % NXCD, off = wgid / NXCD; wgid = (xcd < r ? xcd * (q + 1) : r * (q + 1) + (xcd - r) * q) + off; }
        const int nig = WGM * nN, gid = wgid / nig, fm = gid * WGM, gsz = (nM - fm) < WGM ? (nM - fm) : WGM;
        u.pm = fm + ((wgid % nig) % gsz); u.pn = (wgid % nig) / gsz; return true;
    }
    __device__ __forceinline__ void a_ready(const Unit&) const {}
    __device__ __forceinline__ void done(const Unit&) const {}
};
__device__ __forceinline__ unsigned cvt_pk_bf16(float lo, float hi) { unsigned r; asm volatile("v_cvt_pk_bf16_f32 %0, %1, %2" : "=v"(r) : "v"(lo), "v"(hi)); return r; }
typedef float f32x2 __attribute__((ext_vector_type(2)));
__device__ __forceinline__ float fast_sigmoid(float t) { return __builtin_amdgcn_rcpf(1.0f + __builtin_amdgcn_exp2f(-1.44269504089f * t)); }
__device__ __forceinline__ float gelu_tanh(float x) { const float t = 1.5957691216057308f * (x + 0.044715f * x * x * x); return x * fast_sigmoid(t); }
__device__ __forceinline__ float silu_f(float x) { return x * fast_sigmoid(x); }
typedef unsigned u32x2 __attribute__((ext_vector_type(2)));

struct EpiProj {
    static constexpr bool PERM = false, AFTER_DRAIN = false, KSPLIT = false;
    bf16_t* O; const float* rope; float qscale;
    __device__ __forceinline__ void operator()(const f32x4 (&acc)[2][2][4][2], const Unit& u, int wr, int wc, int fr, int fq) const {
        const int row0 = u.pm * BM + wr * 64 + fr, col0 = u.pn * BM + wc * 32 + 4 * fq;
        const int kind = u.pn >> 2;
        const bool do_rope = (kind == 2 || kind == 3) && (wc == 0);
#pragma unroll
        for (int ai = 0; ai < 2; ++ai)
#pragma unroll
            for (int m = 0; m < 4; ++m) {
                const int row = row0 + ai * HALF + m * 16;
                const int pos = row < 8192 ? row : row - 8192;
                bf16_t* rowp = O + (size_t)row * 5120 + col0;
                f32x4 cs = (f32x4){1.f, 1.f, 1.f, 1.f}, sn = (f32x4){0.f, 0.f, 0.f, 0.f};
                if (do_rope) { cs = *(const f32x4*)(rope + pos * 32 + 4 * fq); sn = *(const f32x4*)(rope + pos * 32 + 16 + 4 * fq); }
#pragma unroll
                for (int bj = 0; bj < 2; ++bj) {
                    f32x4 v0 = acc[ai][bj][m][0], v1 = acc[ai][bj][m][1];
                    if (kind < 2) {
#pragma unroll
                        for (int j = 0; j < 4; ++j) { v0[j] = gelu_tanh(v0[j]); v1[j] = gelu_tanh(v1[j]); }
                    } else if (do_rope) {
                        const f32x4 o0 = v0 * cs - v1 * sn, o1 = v1 * cs + v0 * sn; v0 = o0; v1 = o1;
                    }
                    if (kind == 2) { v0 = v0 * qscale; v1 = v1 * qscale; }
                    u32x2 w0, w1; w0.x = cvt_pk_bf16(v0[0], v0[1]); w0.y = cvt_pk_bf16(v0[2], v0[3]); w1.x = cvt_pk_bf16(v1[0], v1[1]); w1.y = cvt_pk_bf16(v1[2], v1[3]);
                    *(u32x2*)(rowp + bj * HALF) = w0; *(u32x2*)(rowp + bj * HALF + 16) = w1;
                }
            }
    }
};
struct EpiGU {
    static constexpr bool PERM = true, AFTER_DRAIN = false, KSPLIT = false;
    bf16_t* O;
    __device__ __forceinline__ void operator()(const f32x4 (&acc)[2][2][4][2], const Unit& u, int wr, int wc, int fr, int fq) const {
        const int row0 = u.pm * BM + wr * 64 + fr, col0 = u.pn * HALF + wc * 32 + 8 * fq;
#pragma unroll
        for (int ai = 0; ai < 2; ++ai)
#pragma unroll
            for (int m = 0; m < 4; ++m) {
                bf16_t* rowp = O + (size_t)(row0 + ai * HALF + m * 16) * 5632 + col0;
                f32x4 r0, r1;
#pragma unroll
                for (int j = 0; j < 4; ++j) { r0[j] = silu_f(acc[ai][0][m][0][j]) * acc[ai][1][m][0][j]; r1[j] = silu_f(acc[ai][0][m][1][j]) * acc[ai][1][m][1][j]; }
                u32x4 w; w.x = cvt_pk_bf16(r0[0], r0[1]); w.y = cvt_pk_bf16(r0[2], r0[3]); w.z = cvt_pk_bf16(r1[0], r1[1]); w.w = cvt_pk_bf16(r1[2], r1[3]);
                *(u32x4*)rowp = w;
            }
    }
};
struct EpiMix {
    static constexpr bool PERM = true, AFTER_DRAIN = false, KSPLIT = false;
    bf16_t* O; float* ss;
    __device__ __forceinline__ void operator()(const f32x4 (&acc)[2][2][4][2], const Unit& u, int wr, int wc, int fr, int fq) const {
        const int row0 = u.pm * BM + wr * 64 + fr, col0 = u.pn * BM + wc * 32 + 8 * fq;
#pragma unroll
        for (int ai = 0; ai < 2; ++ai)
#pragma unroll
            for (int m = 0; m < 4; ++m) {
                const int row = row0 + ai * HALF + m * 16;
                bf16_t* rowp = O + (size_t)row * 2048 + col0;
                float s = 0.f;
#pragma unroll
                for (int bj = 0; bj < 2; ++bj) {
                    const f32x4 v0 = acc[ai][bj][m][0], v1 = acc[ai][bj][m][1];
                    s += (v0[0] * v0[0] + v0[1] * v0[1]) + (v0[2] * v0[2] + v0[3] * v0[3]) + (v1[0] * v1[0] + v1[1] * v1[1]) + (v1[2] * v1[2] + v1[3] * v1[3]);
                    u32x4 w; w.x = cvt_pk_bf16(v0[0], v0[1]); w.y = cvt_pk_bf16(v0[2], v0[3]); w.z = cvt_pk_bf16(v1[0], v1[1]); w.w = cvt_pk_bf16(v1[2], v1[3]);
                    *(u32x4*)(rowp + bj * HALF) = w;
                }
                s += __shfl_xor(s, 16); s += __shfl_xor(s, 32);
                if (fq == 0) ss[(size_t)row * 32 + u.pn * 4 + wc] = s;
            }
    }
};

struct EpiMixKS {
    static constexpr bool PERM = true, AFTER_DRAIN = false, KSPLIT = true;
    bf16_t* O; float* ss; const float* ssA; const float* ssB; PG8_LAS float* tbl; int Trows;
    __device__ __forceinline__ void prep(const Unit& u, int ui, int tid) const {
        if (tid < 256) {
            const int row = u.pm * BM + tid; float sa = 0.f, sb = 0.f;
#pragma unroll
            for (int g = 0; g < 8; ++g) { sa += ssA[(size_t)g * Trows + row]; sb += ssB[(size_t)g * Trows + row]; }
            const float rA = 1.0f / sqrtf(sa * (1.0f / 1024.0f) + 1e-6f), rB = 1.0f / sqrtf(sb * (1.0f / 1024.0f) + 1e-6f);
            tbl[(ui & 1) * 512 + tid * 2 + 0] = rA / rB; tbl[(ui & 1) * 512 + tid * 2 + 1] = rB;
        }
    }
    __device__ __forceinline__ void mid(f32x4 (&acc)[2][2][4][2], int ui, int wr, int fr) const {
#pragma unroll
        for (int ai = 0; ai < 2; ++ai)
#pragma unroll
            for (int m = 0; m < 4; ++m) { const float sc = tbl[(ui & 1) * 512 + (ai * HALF + wr * 64 + m * 16 + fr) * 2];
#pragma unroll
                for (int bj = 0; bj < 2; ++bj)
#pragma unroll
                    for (int n = 0; n < 2; ++n) acc[ai][bj][m][n] = acc[ai][bj][m][n] * sc; }
    }
    __device__ __forceinline__ void epi_ks(const f32x4 (&acc)[2][2][4][2], const Unit& u, int ui, int wr, int wc, int fr, int fq) const {
        const int row0 = u.pm * BM + wr * 64 + fr, col0 = u.pn * BM + wc * 32 + 8 * fq;
#pragma unroll
        for (int ai = 0; ai < 2; ++ai)
#pragma unroll
            for (int m = 0; m < 4; ++m) {
                const int row = row0 + ai * HALF + m * 16;
                const float sc = tbl[(ui & 1) * 512 + (ai * HALF + wr * 64 + m * 16 + fr) * 2 + 1];
                bf16_t* rowp = O + (size_t)row * 2048 + col0;
                float s = 0.f;
#pragma unroll
                for (int bj = 0; bj < 2; ++bj) {
                    const f32x4 v0 = acc[ai][bj][m][0] * sc, v1 = acc[ai][bj][m][1] * sc;
                    s += (v0[0] * v0[0] + v0[1] * v0[1]) + (v0[2] * v0[2] + v0[3] * v0[3]) + (v1[0] * v1[0] + v1[1] * v1[1]) + (v1[2] * v1[2] + v1[3] * v1[3]);
                    u32x4 w; w.x = cvt_pk_bf16(v0[0], v0[1]); w.y = cvt_pk_bf16(v0[2], v0[3]); w.z = cvt_pk_bf16(v1[0], v1[1]); w.w = cvt_pk_bf16(v1[2], v1[3]);
                    *(u32x4*)(rowp + bj * HALF) = w;
                }
                s += __shfl_xor(s, 16); s += __shfl_xor(s, 32);
                if (fq == 0) ss[(size_t)row * 32 + u.pn * 4 + wc] = s;
            }
    }
    __device__ __forceinline__ void operator()(const f32x4 (&)[2][2][4][2], const Unit&, int, int, int, int) const {}
};

template <class Epi, class Sched, bool ALIGN_EPI = false, bool SP2 = false>
__device__ __forceinline__ void gemm_phase(PG8_LAS unsigned char* lds, const Gemm g, const Sched& S, const Epi& E, int wave_s) {
    int tid_ = fresh_tid(wave_s); asm volatile("" : "+v"(tid_));
    const int tid = tid_, wid = __builtin_amdgcn_readfirstlane(tid >> 6), lane = tid & 63, wr = wid >> 2, wc = wid & 3, fr = lane & 15, fq = lane >> 4;
    const int K = g.K, nt = K / BK;
    unsigned voffA[2], voffB[2];
#pragma unroll
    for (int i = 0; i < 2; ++i) { int R, C; stage_rc(tid * 16 + i * 8192, R, C); const int Rb = Epi::PERM ? ((R & ~31) + perm32(R & 31)) : R;
        voffA[i] = (unsigned)(R * K + C) * 2u; voffB[i] = (unsigned)(Rb * K + C) * 2u; }
    const size_t kstep = (size_t)(BK * 2);
    const size_t hstep = (size_t)HALF * K * 2;
    const size_t tstep = 2 * hstep;
    const unsigned ldsw = (unsigned)wid * 1024u;
    const int aoff = lds_byte(wr * 64 + fr, fq * 8), boff = lds_byte(wc * 32 + fr, fq * 8);
#define PG8_SA(b, h) (((b) * 2 + (h)) * HTB)
#define PG8_SB(b, h) ((4 + (b) * 2 + (h)) * HTB)
#define PG8_STAGE(bufoff, gbase, voff) do { _Pragma("unroll") for (int _i = 0; _i < 2; ++_i) \
        __builtin_amdgcn_global_load_lds((const unsigned*)((const char*)(gbase) + (voff)[_i]), (PG8_LAS unsigned*)(lds + (bufoff) + ldsw + _i * 8192), 16, 0, 0); } while (0)
#define PG8_LDA(dst, b, h) do { _Pragma("unroll") for (int m = 0; m < 4; ++m) _Pragma("unroll") for (int k = 0; k < 2; ++k) dst[m][k] = *(const PG8_LAS bf16x8*)(lds + PG8_SA(b, h) + aoff + m * 2048 + k * 1024); } while (0)
#define PG8_LDB(dst, b, h) do { _Pragma("unroll") for (int n = 0; n < 2; ++n) _Pragma("unroll") for (int k = 0; k < 2; ++k) dst[n][k] = *(const PG8_LAS bf16x8*)(lds + PG8_SB(b, h) + boff + n * 2048 + k * 1024); } while (0)
#define PG8_MMA(ai, bj, At, Bt) do { __builtin_amdgcn_s_setprio(1); _Pragma("unroll") for (int m = 0; m < 4; ++m) _Pragma("unroll") for (int n = 0; n < 2; ++n) _Pragma("unroll") for (int k = 0; k < 2; ++k) \
        acc[ai][bj][m][n] = __builtin_amdgcn_mfma_f32_16x16x32_bf16(Bt[n][k], At[m][k], acc[ai][bj][m][n], 0, 0, 0); __builtin_amdgcn_s_setprio(0); } while (0)
#define PG8_WAIT_V(n) asm volatile("s_waitcnt vmcnt(" #n ")" ::: "memory")
#define PG8_WAIT_L(n) asm volatile("s_waitcnt lgkmcnt(" #n ")" ::: "memory")
#define PG8_BAR __builtin_amdgcn_s_barrier()
#define PG8_SCHED __builtin_amdgcn_sched_barrier(0)
    Unit cur, nxt; int ui = 0;
    if (!S.next(0, cur)) return;
    if constexpr (Epi::KSPLIT) E.prep(cur, 0, tid);
    f32x4 acc[2][2][4][2];
#pragma unroll
    for (int a = 0; a < 2; ++a)
#pragma unroll
        for (int b = 0; b < 2; ++b)
#pragma unroll
            for (int m = 0; m < 4; ++m)
#pragma unroll
                for (int n = 0; n < 2; ++n) acc[a][b][m][n] = (f32x4){0.f, 0.f, 0.f, 0.f};
    bf16x8 At[4][2], B0[2][2], B1[2][2];
    const char* cA = (const char*)g.A + (size_t)cur.pm * tstep; const char* cB = (const char*)g.Bt + (size_t)cur.pn * tstep;
    S.a_ready(cur);
    if constexpr (SP2) {
        PG8_STAGE(PG8_SB(0, 0), cB, voffB); PG8_STAGE(PG8_SB(0, 1), cB + hstep, voffB); PG8_STAGE(PG8_SA(0, 0), cA, voffA); PG8_STAGE(PG8_SA(0, 1), cA + hstep, voffA);
        if (wr == 1) PG8_BAR;
        PG8_WAIT_V(2); PG8_BAR;
        PG8_STAGE(PG8_SB(1, 0), cB + kstep, voffB); PG8_STAGE(PG8_SA(1, 0), cA + kstep, voffA); PG8_STAGE(PG8_SB(1, 1), cB + hstep + kstep, voffB);
        PG8_WAIT_V(6); PG8_BAR;
    } else {
        PG8_STAGE(PG8_SB(0, 0), cB, voffB); PG8_STAGE(PG8_SA(0, 0), cA, voffA); PG8_STAGE(PG8_SB(0, 1), cB + hstep, voffB); PG8_STAGE(PG8_SA(0, 1), cA + hstep, voffA);
        if (wr == 1) PG8_BAR;
        PG8_WAIT_V(4); PG8_BAR;
        PG8_STAGE(PG8_SB(1, 0), cB + kstep, voffB); PG8_STAGE(PG8_SA(1, 0), cA + kstep, voffA); PG8_STAGE(PG8_SB(1, 1), cB + hstep + kstep, voffB);
        PG8_WAIT_V(6); PG8_BAR;
    }
    for (;;) {
        const bool has_next = S.next(ui + 1, nxt);
        const char* nA = has_next ? (const char*)g.A + (size_t)nxt.pm * tstep : cA; const char* nB = has_next ? (const char*)g.Bt + (size_t)nxt.pn * tstep : cB;
        for (int t = 0; t < nt; t += 2) {
            if constexpr (Epi::KSPLIT) { if (t == (nt >> 1)) E.mid(acc, ui, wr, fr); }
            const bool last = (t == nt - 2);
            const char* a1 = cA + (size_t)(t + 1) * kstep;
            const char* a2 = last ? nA : cA + (size_t)(t + 2) * kstep; const char* b2 = last ? nB : cB + (size_t)(t + 2) * kstep;
            const char* a3 = a2 + kstep; const char* b3 = b2 + kstep;
            if (last && has_next) S.a_ready(nxt);
            if constexpr (SP2) {
            PG8_LDB(B0, 0, 0); PG8_LDB(B1, 0, 1); PG8_SCHED; PG8_LDA(At, 0, 0); PG8_STAGE(PG8_SA(1, 1), a1 + hstep, voffA);
            PG8_WAIT_V(8); PG8_WAIT_L(0); PG8_BAR; PG8_MMA(0, 0, At, B0); PG8_MMA(0, 1, At, B1); PG8_BAR; PG8_SCHED;
            PG8_LDA(At, 0, 1); PG8_STAGE(PG8_SB(0, 0), b2, voffB); PG8_STAGE(PG8_SB(0, 1), b2 + hstep, voffB); PG8_STAGE(PG8_SA(0, 0), a2, voffA);
            PG8_WAIT_V(8); PG8_WAIT_L(0); PG8_BAR; PG8_MMA(1, 0, At, B0); PG8_MMA(1, 1, At, B1); PG8_BAR; PG8_SCHED;
            PG8_LDB(B0, 1, 0); PG8_LDB(B1, 1, 1); PG8_SCHED; PG8_LDA(At, 1, 0); PG8_STAGE(PG8_SA(0, 1), a2 + hstep, voffA);
            PG8_WAIT_V(8); PG8_WAIT_L(0); PG8_BAR; PG8_MMA(0, 0, At, B0); PG8_MMA(0, 1, At, B1); PG8_BAR; PG8_SCHED;
            PG8_LDA(At, 1, 1); PG8_STAGE(PG8_SB(1, 0), b3, voffB); PG8_STAGE(PG8_SB(1, 1), b3 + hstep, voffB); PG8_STAGE(PG8_SA(1, 0), a3, voffA);
            PG8_WAIT_V(8); PG8_WAIT_L(0); PG8_BAR; PG8_MMA(1, 0, At, B0); PG8_MMA(1, 1, At, B1); PG8_BAR; PG8_SCHED;
            } else {
            PG8_LDB(B0, 0, 0); PG8_SCHED; PG8_LDA(At, 0, 0); PG8_STAGE(PG8_SA(1, 1), a1 + hstep, voffA);
            PG8_WAIT_L(8); PG8_BAR; PG8_WAIT_L(0); PG8_MMA(0, 0, At, B0); PG8_BAR; PG8_SCHED;
            PG8_LDB(B1, 0, 1); PG8_STAGE(PG8_SB(0, 0), b2, voffB);
            PG8_BAR; PG8_WAIT_L(0); PG8_MMA(0, 1, At, B1); PG8_BAR;
            PG8_LDA(At, 0, 1); PG8_STAGE(PG8_SA(0, 0), a2, voffA);
            PG8_BAR; PG8_WAIT_L(0); PG8_MMA(1, 0, At, B0); PG8_BAR; PG8_SCHED;
            PG8_STAGE(PG8_SB(0, 1), b2 + hstep, voffB);
            PG8_WAIT_V(6); PG8_BAR; PG8_MMA(1, 1, At, B1); PG8_BAR;
            PG8_LDB(B0, 1, 0); PG8_SCHED; PG8_LDA(At, 1, 0); PG8_STAGE(PG8_SA(0, 1), a2 + hstep, voffA);
            PG8_WAIT_L(8); PG8_BAR; PG8_WAIT_L(0); PG8_MMA(0, 0, At, B0); PG8_BAR; PG8_SCHED;
            PG8_LDB(B1, 1, 1); PG8_STAGE(PG8_SB(1, 0), b3, voffB);
            PG8_BAR; PG8_WAIT_L(0); PG8_MMA(0, 1, At, B1); PG8_BAR;
            PG8_LDA(At, 1, 1); PG8_STAGE(PG8_SA(1, 0), a3, voffA);
            PG8_BAR; PG8_WAIT_L(0); PG8_MMA(1, 0, At, B0); PG8_BAR; PG8_SCHED;
            PG8_STAGE(PG8_SB(1, 1), b3 + hstep, voffB);
            PG8_WAIT_V(6); PG8_BAR; PG8_MMA(1, 1, At, B1); PG8_BAR;
            }
        }
        if constexpr (ALIGN_EPI) { if (wr == 0) PG8_BAR; }
        if constexpr (!Epi::AFTER_DRAIN) { if constexpr (Epi::KSPLIT) E.epi_ks(acc, cur, ui, wr, wc, fr, fq); else E(acc, cur, wr, wc, fr, fq); S.done(cur); }
        if (!has_next) break;
#pragma unroll
        for (int a = 0; a < 2; ++a)
#pragma unroll
            for (int b = 0; b < 2; ++b)
#pragma unroll
                for (int m = 0; m < 4; ++m)
#pragma unroll
                    for (int n = 0; n < 2; ++n) acc[a][b][m][n] = (f32x4){0.f, 0.f, 0.f, 0.f};
        cur = nxt; cA = nA; cB = nB; ++ui;
        if constexpr (Epi::KSPLIT) E.prep(cur, ui, tid);
        if constexpr (ALIGN_EPI) { if (wr == 1) PG8_BAR; }
    }
    PG8_WAIT_V(0);
    if constexpr (!ALIGN_EPI) { if (wr == 0) PG8_BAR; }
    PG8_BAR;
    if constexpr (Epi::AFTER_DRAIN) { E.fused(acc, cur, wr, wc, fr, fq, lds, wid, lane); S.done(cur); }
#undef PG8_SA
#undef PG8_SB
#undef PG8_STAGE
#undef PG8_LDA
#undef PG8_LDB
#undef PG8_MMA
#undef PG8_WAIT_V
#undef PG8_WAIT_L
#undef PG8_BAR
#undef PG8_SCHED
}
}
#define LAS __attribute__((address_space(3)))
typedef unsigned short bf16;
typedef float f32x4 __attribute__((ext_vector_type(4)));
typedef float f32x16 __attribute__((ext_vector_type(16)));
typedef short bf16x8 __attribute__((ext_vector_type(8)));
typedef short s16x4 __attribute__((ext_vector_type(4)));
typedef unsigned v4u __attribute__((ext_vector_type(4)));
typedef unsigned v2u __attribute__((ext_vector_type(2)));

constexpr int NWAVES = 8, NTHREADS = 512;
constexpr int T_P = 8192, T_S = 16384, T = T_P + T_S, D = 2048, PW = 5120, FF = 5632, DEPTH = 4;
constexpr int C_U = 0, C_VA = 1024, C_Q = 2048, C_K = 3072, C_V = 4096;
constexpr float EPS = 1e-6f;
constexpr float QSCALE = 0.08838834764831845f * 1.4426950408889634f;

constexpr size_t MiB = 1u << 20;
constexpr size_t WS_CTL = 0;
constexpr size_t WS_ROPE = 1 * MiB;
constexpr size_t WS_WSB = 3 * MiB;
constexpr size_t WS_SSA = 4 * MiB;
constexpr size_t WS_SSB = 5 * MiB;
constexpr size_t WS_SSM = 6 * MiB;
constexpr size_t WS_LSE = 9 * MiB;
constexpr size_t WS_WIN = 12 * MiB;
constexpr size_t WS_WO = 92 * MiB;
constexpr size_t WS_WGU = 124 * MiB;
constexpr size_t WS_WDN = 300 * MiB;
constexpr size_t WS_H = 388 * MiB;
constexpr size_t WS_R1 = 484 * MiB;
constexpr size_t WS_MIX = 748 * MiB;
constexpr size_t WS_END = 844 * MiB;
constexpr int LDS_BYTES = 147456, MISC_OFF = 131072 + 12288;

__device__ __forceinline__ unsigned cvtpk(float lo, float hi) { unsigned r; asm volatile("v_cvt_pk_bf16_f32 %0, %1, %2" : "=v"(r) : "v"(lo), "v"(hi)); return r; }
__device__ __forceinline__ float bflo(unsigned w) { return __uint_as_float(w << 16); }
__device__ __forceinline__ float bfhi(unsigned w) { return __uint_as_float(w & 0xffff0000u); }
__device__ __forceinline__ float wave_sum(float v) {
#pragma unroll
    for (int o = 1; o < 64; o <<= 1) v += __shfl_xor(v, o);
    return v;
}

struct Args { const float* in[16]; float* out; unsigned char* ws; };

__device__ __forceinline__ void transpose_item(const float* W, int K, int N, bf16* WT, int mode, LAS float* scr, int item, int lane, const float* kscale = nullptr) {
    const int nblk = N / 32, kb = item / nblk, nb = item % nblk, k0 = 64 * kb, n0 = 32 * nb;
    const int drow0 = mode == 0 ? n0 : (256 * (n0 >> 7) + (n0 & 127) + (mode == 2 ? 128 : 0));
#pragma unroll 8
    for (int i = 0; i < 32; ++i) { const int kk = 2 * i + (lane >> 5); float w = W[(size_t)(k0 + kk) * N + n0 + (lane & 31)]; if (kscale) w *= kscale[k0 + kk]; scr[kk * 33 + (lane & 31)] = w; }
    asm volatile("s_waitcnt lgkmcnt(0)" ::: "memory");
    const int c = lane & 7;
#pragma unroll
    for (int j = 0; j < 4; ++j) { const int n = (lane >> 3) + 8 * j; const LAS float* s = scr + (8 * c) * 33 + n;
        v4u o; o.x = cvtpk(s[0 * 33], s[1 * 33]); o.y = cvtpk(s[2 * 33], s[3 * 33]); o.z = cvtpk(s[4 * 33], s[5 * 33]); o.w = cvtpk(s[6 * 33], s[7 * 33]);
        *(v4u*)(WT + (size_t)(drow0 + n) * K + k0 + 8 * c) = o; }
    asm volatile("s_waitcnt lgkmcnt(0)" ::: "memory");
}

__device__ __forceinline__ void prologue_phase(const Args& a, LAS unsigned char* lds, int gw, int NGW, int wave, int lane) {
    unsigned char* ws = a.ws;
    LAS float* scr = (LAS float*)(lds + wave * 16384);
    constexpr int I_IN = (D / 64) * (PW / 32), I_O = (D / 64) * (D / 32), I_G = (D / 64) * (FF / 32), I_D = (FF / 64) * (D / 32);
    constexpr int PER_L = I_IN + I_O + 2 * I_G + I_D;
    for (int it = gw; it < DEPTH * PER_L; it += NGW) {
        const int l = it / PER_L; int r = it % PER_L;
        if (r < I_IN) { transpose_item(a.in[3] + (size_t)l * D * PW, D, PW, (bf16*)(ws + WS_WIN) + (size_t)l * PW * D, 0, scr, r, lane); continue; } r -= I_IN;
        if (r < I_O) { const int kb_ = r / (D / 32);
            const float* ks = (kb_ < 16 ? a.in[7] + (size_t)l * 1024 : a.in[8] + (size_t)l * 1024 - 1024);
            transpose_item(a.in[9] + (size_t)l * D * D, D, D, (bf16*)(ws + WS_WO) + (size_t)l * D * D, 0, scr, r, lane, ks); continue; } r -= I_O;
        if (r < I_G) { transpose_item(a.in[12] + (size_t)l * D * FF, D, FF, (bf16*)(ws + WS_WGU) + (size_t)l * 2 * FF * D, 1, scr, r, lane); continue; } r -= I_G;
        if (r < I_G) { transpose_item(a.in[13] + (size_t)l * D * FF, D, FF, (bf16*)(ws + WS_WGU) + (size_t)l * 2 * FF * D, 2, scr, r, lane); continue; } r -= I_G;
        transpose_item(a.in[14] + (size_t)l * FF * D, FF, D, (bf16*)(ws + WS_WDN) + (size_t)l * D * FF, 0, scr, r, lane);
    }
    { const float* src = a.in[5]; bf16* dst = (bf16*)(ws + WS_WSB); const int n4 = DEPTH * 8 * 128 * 128 / 4;
      for (int i = gw * 64 + lane; i < n4; i += NGW * 64) { const f32x4 v = ((const f32x4*)src)[i]; v2u o; o.x = cvtpk(v[0], v[1]); o.y = cvtpk(v[2], v[3]); ((v2u*)dst)[i] = o; } }
    { float* tab = (float*)(ws + WS_ROPE);
      for (int i = gw * 64 + lane; i < 16384 * 16; i += NGW * 64) { const int pos = i >> 4, f = i & 15;
          const float inv = (float)pow(500000.0, -(double)f / 16.0); const float ang = (float)pos * inv;
          tab[pos * 32 + f] = (float)cos((double)ang); tab[pos * 32 + 16 + f] = (float)sin((double)ang); } }
}

template <bool FIRST, bool LAST>
__device__ __forceinline__ void resnorm_phase(const Args& a, const float* g_post, const float* g_next, int gw, int NGW, int lane) {
    unsigned char* ws = a.ws; float* X = a.out; const bf16* MIXb = (const bf16*)(ws + WS_MIX); const float* ssM = (const float*)(ws + WS_SSM); bf16* H = (bf16*)(ws + WS_H);
    f32x4 gp[8], gn[8];
#pragma unroll
    for (int j = 0; j < 8; ++j) { gp[j] = FIRST ? (f32x4){0.f, 0.f, 0.f, 0.f} : ((const f32x4*)g_post)[lane + 64 * j]; gn[j] = LAST ? (f32x4){0.f, 0.f, 0.f, 0.f} : ((const f32x4*)g_next)[lane + 64 * j]; }
    for (int row = gw; row < T; row += NGW) {
        f32x4 v[8];
        if (FIRST) {
            const f32x4* src = (const f32x4*)(row < T_P ? a.in[0] + (size_t)row * D : a.in[1] + (size_t)(row - T_P) * D);
#pragma unroll
            for (int j = 0; j < 8; ++j) v[j] = src[lane + 64 * j];
        } else {
            const f32x4* xr = (const f32x4*)(X + (size_t)row * D);
            const v2u* mp = (const v2u*)(MIXb + (size_t)row * D);
            v2u m[8];
#pragma unroll
            for (int j = 0; j < 8; ++j) { v[j] = xr[lane + 64 * j]; m[j] = mp[lane + 64 * j]; }
            const float ssp = lane < 32 ? ssM[(size_t)row * 32 + lane] : 0.f;
            const float rinv = 1.0f / sqrtf(wave_sum(ssp) * (1.0f / D) + EPS);
#pragma unroll
            for (int j = 0; j < 8; ++j) {
                v[j][0] += bflo(m[j].x) * rinv * gp[j][0]; v[j][1] += bfhi(m[j].x) * rinv * gp[j][1]; v[j][2] += bflo(m[j].y) * rinv * gp[j][2]; v[j][3] += bfhi(m[j].y) * rinv * gp[j][3]; }
        }
        f32x4* xo = (f32x4*)(X + (size_t)row * D);
#pragma unroll
        for (int j = 0; j < 8; ++j) xo[lane + 64 * j] = v[j];
        if (!LAST) {
            float s2 = 0.f;
#pragma unroll
            for (int j = 0; j < 8; ++j) s2 += (v[j][0] * v[j][0] + v[j][1] * v[j][1]) + (v[j][2] * v[j][2] + v[j][3] * v[j][3]);
            const float r2 = 1.0f / sqrtf(wave_sum(s2) * (1.0f / D) + EPS);
            v2u* ho = (v2u*)(H + (size_t)row * D);
#pragma unroll
            for (int j = 0; j < 8; ++j) { v2u o; o.x = cvtpk(v[j][0] * r2 * gn[j][0], v[j][1] * r2 * gn[j][1]); o.y = cvtpk(v[j][2] * r2 * gn[j][2], v[j][3] * r2 * gn[j][3]); ho[lane + 64 * j] = o; }
        }
    }
}

__device__ __forceinline__ void mnorm_phase(const Args& a, const float* gA, const float* gB, int gw, int NGW, int lane) {
    unsigned char* ws = a.ws; bf16* MG = (bf16*)(ws + WS_H); const float* ssA = (const float*)(ws + WS_SSA); const float* ssB = (const float*)(ws + WS_SSB);
    for (int row = gw; row < T; row += NGW) {
        float p = lane < 8 ? ssA[(size_t)lane * T + row] : (lane < 16 ? ssB[(size_t)(lane - 8) * T + row] : 0.f);
        p += __shfl_xor(p, 1); p += __shfl_xor(p, 2); p += __shfl_xor(p, 4);
        const float sa = __shfl(p, 0), sb = __shfl(p, 8);
        const float rA = 1.0f / sqrtf(sa * (1.0f / 1024.0f) + EPS), rB = 1.0f / sqrtf(sb * (1.0f / 1024.0f) + EPS);
        v4u* rp = (v4u*)(MG + (size_t)row * D);
#pragma unroll
        for (int j = 0; j < 4; ++j) {
            const int ch = lane + 64 * j; v4u w = rp[ch];
            const float r = j < 2 ? rA : rB; const float* g = (j < 2 ? gA : gB) + (ch & 127) * 8;
            const f32x4 g0 = *(const f32x4*)g, g1 = *(const f32x4*)(g + 4);
            v4u o; o.x = cvtpk(bflo(w.x) * r * g0[0], bfhi(w.x) * r * g0[1]); o.y = cvtpk(bflo(w.y) * r * g0[2], bfhi(w.y) * r * g0[3]);
            o.z = cvtpk(bflo(w.z) * r * g1[0], bfhi(w.z) * r * g1[1]); o.w = cvtpk(bflo(w.w) * r * g1[2], bfhi(w.w) * r * g1[3]);
            rp[ch] = o;
        }
    }
}

constexpr int GM_LDT = 136;
__device__ __forceinline__ void gmlp_item(const Args& a, int layer, int chunk, int g, LAS unsigned char* lds, int tid_in, int wave, int lane_in) {
    int tid = tid_in; asm volatile("" : "+v"(tid)); const int lane = tid & 63; (void)lane_in;
    unsigned char* ws = a.ws; const bf16* PROJ = (const bf16*)(ws + WS_R1); bf16* MG = (bf16*)(ws + WS_H);
    LAS bf16* Vt = (LAS bf16*)lds;
    LAS float* ssl = (LAS float*)(lds + (128 * GM_LDT + 64) * 2);
    const int R0 = chunk * 128;
    const int tq = wave & 3, chh = wave >> 2, hf = lane >> 5, l31 = lane & 31;
    const int t = 32 * tq + l31, row = R0 + t;
    bf16x8 bfr[8]; v2u uw[2][4];
    { const bf16* wsb = (const bf16*)(ws + WS_WSB) + ((size_t)(layer * 8 + g) * 128 + t) * 128 + 8 * hf;
#pragma unroll
      for (int ks = 0; ks < 8; ++ks) bfr[ks] = *(const bf16x8*)(wsb + 16 * ks);
      const bf16* up = PROJ + (size_t)row * PW + C_U + g * 128 + 64 * chh + 4 * hf;
#pragma unroll
      for (int cb = 0; cb < 2; ++cb)
#pragma unroll
          for (int g4 = 0; g4 < 4; ++g4) uw[cb][g4] = *(const v2u*)(up + 32 * cb + 8 * g4); }
    const float bias = a.in[6][(size_t)layer * 1024 + g * 128 + t];
    {
        const int s = tid >> 2, q = tid & 3;
        const v4u* vp = (const v4u*)(PROJ + (size_t)(R0 + s) * PW + C_VA + g * 128 + 32 * q);
        float x[32];
#pragma unroll
        for (int i = 0; i < 4; ++i) { const v4u w = vp[i]; x[8 * i + 0] = bflo(w.x); x[8 * i + 1] = bfhi(w.x); x[8 * i + 2] = bflo(w.y); x[8 * i + 3] = bfhi(w.y);
            x[8 * i + 4] = bflo(w.z); x[8 * i + 5] = bfhi(w.z); x[8 * i + 6] = bflo(w.w); x[8 * i + 7] = bfhi(w.w); }
        float sm = 0.f;
#pragma unroll
        for (int i = 0; i < 32; ++i) sm += x[i];
        sm += __shfl_xor(sm, 1); sm += __shfl_xor(sm, 2);
        const float mu = sm * (1.0f / 128.0f); float vq = 0.f;
#pragma unroll
        for (int i = 0; i < 32; ++i) { x[i] -= mu; vq += x[i] * x[i]; }
        vq += __shfl_xor(vq, 1); vq += __shfl_xor(vq, 2);
        const float rs = 1.0f / sqrtf(vq * (1.0f / 128.0f) + EPS);
        const f32x4* gn4 = (const f32x4*)(a.in[4] + (size_t)layer * 1024 + g * 128 + 32 * q);
        float gn[32];
#pragma unroll
        for (int i = 0; i < 8; ++i) { const f32x4 gv = gn4[i]; gn[4 * i] = gv[0]; gn[4 * i + 1] = gv[1]; gn[4 * i + 2] = gv[2]; gn[4 * i + 3] = gv[3]; }
#pragma unroll
        for (int i = 0; i < 32; i += 2) { const unsigned w = cvtpk(x[i] * rs * gn[i], x[i + 1] * rs * gn[i + 1]);
            Vt[(32 * q + i) * GM_LDT + 16 * q + s] = (bf16)(w & 0xffffu); Vt[(32 * q + i + 1) * GM_LDT + 16 * q + s] = (bf16)(w >> 16); }
    }
    __syncthreads();
    {
        f32x16 acc0, acc1;
#pragma unroll
        for (int i = 0; i < 16; ++i) { acc0[i] = 0.f; acc1[i] = 0.f; }
#pragma unroll
        for (int ks = 0; ks < 8; ++ks) {
            const bf16x8 a0 = *(const LAS bf16x8*)(Vt + (64 * chh + l31) * GM_LDT + 16 * (2 * chh) + 16 * ks + 8 * hf);
            const bf16x8 a1 = *(const LAS bf16x8*)(Vt + (64 * chh + 32 + l31) * GM_LDT + 16 * (2 * chh + 1) + 16 * ks + 8 * hf);
            acc0 = __builtin_amdgcn_mfma_f32_32x32x16_bf16(a0, bfr[ks], acc0, 0, 0, 0);
            acc1 = __builtin_amdgcn_mfma_f32_32x32x16_bf16(a1, bfr[ks], acc1, 0, 0, 0);
        }
        bf16* op = MG + (size_t)row * D + g * 128 + 64 * chh + 4 * hf;
        float ss = 0.f;
#pragma unroll
        for (int cb = 0; cb < 2; ++cb)
#pragma unroll
            for (int g4 = 0; g4 < 4; ++g4) {
                const v2u uwv = uw[cb][g4];
                float o0, o1, o2, o3;
                if (cb == 0) { o0 = bflo(uwv.x) * (acc0[4 * g4 + 0] + bias); o1 = bfhi(uwv.x) * (acc0[4 * g4 + 1] + bias); o2 = bflo(uwv.y) * (acc0[4 * g4 + 2] + bias); o3 = bfhi(uwv.y) * (acc0[4 * g4 + 3] + bias); }
                else         { o0 = bflo(uwv.x) * (acc1[4 * g4 + 0] + bias); o1 = bfhi(uwv.x) * (acc1[4 * g4 + 1] + bias); o2 = bflo(uwv.y) * (acc1[4 * g4 + 2] + bias); o3 = bfhi(uwv.y) * (acc1[4 * g4 + 3] + bias); }
                ss += (o0 * o0 + o1 * o1) + (o2 * o2 + o3 * o3);
                v2u ow; ow.x = cvtpk(o0, o1); ow.y = cvtpk(o2, o3);
                *(v2u*)(op + 32 * cb + 8 * g4) = ow;
            }
        ss += __shfl_xor(ss, 32);
        if (hf == 0) ssl[chh * 128 + t] = ss;
    }
    __syncthreads();
    if (tid < 128) ((float*)(ws + WS_SSA))[(size_t)g * T + R0 + tid] = ssl[tid] + ssl[128 + tid];
}

__device__ __forceinline__ unsigned voff_b(unsigned row, unsigned ch) { return 256u * row + 16u * (ch ^ (((row & 3) << 2) | ((row >> 2) & 3))); }
typedef short v4i16_t __attribute__((ext_vector_type(4)));
__device__ __forceinline__ s16x4 vtr(const LAS unsigned char* p) { return __builtin_bit_cast(s16x4, __builtin_amdgcn_ds_read_tr16_b64_v4i16((LAS v4i16_t*)p)); }

__device__ __forceinline__ void glds16(const void* gsrc, unsigned lds_dst) { unsigned keep;
    asm volatile("s_mov_b32 %0, m0\n\ts_mov_b32 m0, %2\n\ts_nop 0\n\tglobal_load_lds_dwordx4 %1, off\n\ts_mov_b32 m0, %0" : "=&s"(keep) : "v"(gsrc), "s"(lds_dst) : "memory"); }
__device__ __forceinline__ void glds16s(const void* sbase, unsigned voff, unsigned lds_dst) { unsigned keep;
    asm volatile("s_mov_b32 %0, m0\n\ts_mov_b32 m0, %3\n\ts_nop 0\n\tglobal_load_lds_dwordx4 %1, %2\n\ts_mov_b32 m0, %0" : "=&s"(keep) : "v"(voff), "s"(sbase), "s"(lds_dst) : "memory"); }
#define ATT_DMA_FAST(FIRST, COLBASE, BUF) do { \
        const bf16* sb_ = PROJ + (size_t)(seq_base + r + dd * (FIRST)) * PW + (COLBASE) + h * 128; \
        const unsigned l0_ = (unsigned)__builtin_amdgcn_readfirstlane((int)(unsigned)(uintptr_t)(BUF)); \
        _Pragma("unroll") for (int i_ = 0; i_ < 8; ++i_) glds16s(sb_ + (size_t)i_ * 4 * dd * PW, voffs[i_ & 3], l0_ + 1024u * i_); \
    } while (0)
#define ATT_DMA_ANY(FIRST, COLBASE, BUF) do { if (edge) ATT_DMA(FIRST, COLBASE, BUF); else ATT_DMA_FAST(FIRST, COLBASE, BUF); } while (0)
#define ATT_DMA(FIRST, COLBASE, BUF) do { \
        int f0_ = (FIRST); asm volatile("" : "+s"(f0_)); \
        _Pragma("unroll") for (int i_ = 0; i_ < 8; ++i_) { const int row_ = 4 * i_ + (lane >> 4); int kj_ = f0_ + row_; kj_ = kj_ < 0 ? 0 : (kj_ >= L ? L - 1 : kj_); \
            const int ch_ = (lane & 15) ^ (((row_ & 3) << 2) | ((row_ >> 2) & 3)); \
            glds16(PROJ + (size_t)(seq_base + r + dd * kj_) * PW + (COLBASE) + h * 128 + 8 * ch_, (unsigned)__builtin_amdgcn_readfirstlane((int)(unsigned)(uintptr_t)((BUF) + 1024 * i_))); } \
    } while (0)
#define ATT_ROWFRAGS(DST, BUF) do { _Pragma("unroll") for (int s_ = 0; s_ < 8; ++s_) DST[s_] = *(const LAS bf16x8*)((BUF) + voff_b(l31, 2 * s_ + hf)); } while (0)
#define ATT_SOFTMAX_PV(KB, VBUF, WAITV) do { \
        if ((KB) == 0) { _Pragma("unroll") for (int i = 0; i < 16; ++i) { if ((i & 3) + 8 * (i >> 2) < lm) S[i] = -1e30f; } }            \
        else if ((KB) == 4) { _Pragma("unroll") for (int i = 0; i < 16; ++i) { if ((i & 3) + 8 * (i >> 2) > lm) S[i] = -1e30f; } }     \
        if (edge) { _Pragma("unroll") for (int i = 0; i < 16; ++i) { const int kj = J0 - 64 + 32 * (KB) + 4 * hf + (i & 3) + 8 * (i >> 2); if (kj < 0 || kj >= L) S[i] = -1e30f; } } \
        float bm = S[0]; \
        _Pragma("unroll") for (int i = 1; i < 16; ++i) bm = fmaxf(bm, S[i]); \
        bm = fmaxf(bm, __shfl_xor(bm, 32)); \
        const float mnew = fmaxf(mrun, bm); \
        const float alpha = __builtin_amdgcn_exp2f(mrun - mnew); \
        mrun = mnew; \
        float ps = 0.f; \
        _Pragma("unroll") for (int i = 0; i < 16; ++i) { S[i] = __builtin_amdgcn_exp2f(S[i] - mnew); ps += S[i]; } \
        lsum = lsum * alpha + ps; \
        _Pragma("unroll") for (int db = 0; db < 4; ++db) _Pragma("unroll") for (int i = 0; i < 16; ++i) O[db][i] *= alpha; \
        bf16x8 pf[2]; \
        _Pragma("unroll") for (int j = 0; j < 2; ++j) { v4u w; w.x = cvtpk(S[8 * j + 0], S[8 * j + 1]); w.y = cvtpk(S[8 * j + 2], S[8 * j + 3]); w.z = cvtpk(S[8 * j + 4], S[8 * j + 5]); w.w = cvtpk(S[8 * j + 6], S[8 * j + 7]); \
            pf[j] = __builtin_bit_cast(bf16x8, w); } \
        WAITV; \
        _Pragma("unroll") for (int db = 0; db < 4; ++db) _Pragma("unroll") for (int j = 0; j < 2; ++j) { \
                const s16x4 lo = vtr((VBUF) + tb[0][db] + 4096 * j); \
                const s16x4 hi = vtr((VBUF) + tb[1][db] + 4096 * j); \
                bf16x8 vf; vf[0] = lo[0]; vf[1] = lo[1]; vf[2] = lo[2]; vf[3] = lo[3]; vf[4] = hi[0]; vf[5] = hi[1]; vf[6] = hi[2]; vf[7] = hi[3]; \
                O[db] = __builtin_amdgcn_mfma_f32_32x32x16_bf16(vf, pf[j], O[db], 0, 0, 0); } \
    } while (0)
__device__ __forceinline__ void attn_wave_tile(const bf16* PROJ, int seq_base, int L, int dd, int r, int J0, int h, LAS unsigned char* vl, bf16* Oscr, float* lse_scr, int P0, int lane, int rot) {
    const int hf = lane >> 5, l31 = lane & 31;
    const bool edge = (J0 < 64) || (J0 + 96 > L);
    const int lm = l31 - 4 * hf;
    LAS unsigned char* kimg = vl; LAS unsigned char* vimg = vl + 8192;
    unsigned voffs[4];
    { const int q_ = lane >> 4;
#pragma unroll
      for (int k = 0; k < 4; ++k) voffs[k] = 2u * (unsigned)(q_ * dd * PW + 8 * ((lane & 15) ^ ((q_ << 2) | k))); }
    bf16x8 qf[8];
    ATT_DMA_FAST(J0, C_Q, kimg);
    asm volatile("s_waitcnt vmcnt(0)" ::: "memory");
    ATT_ROWFRAGS(qf, kimg);
    asm volatile("s_waitcnt lgkmcnt(0)" ::: "memory");
    const int kb0 = __builtin_amdgcn_readfirstlane((5 - rot) % 5);
    ATT_DMA_ANY(J0 - 64 + 32 * kb0, C_K, kimg); ATT_DMA_ANY(J0 - 64 + 32 * kb0, C_V, vimg);
    f32x16 O[4];
#pragma unroll
    for (int db = 0; db < 4; ++db)
#pragma unroll
        for (int i = 0; i < 16; ++i) O[db][i] = 0.f;
    float mrun = -1e30f, lsum = 0.f;
    unsigned tb[2][4];
    { const int blk = (lane >> 4) & 1, q4 = (lane & 15) >> 2, p4 = lane & 3;
#pragma unroll
      for (int t = 0; t < 2; ++t)
#pragma unroll
          for (int db = 0; db < 4; ++db) tb[t][db] = 256u * (4 * hf + q4 + 8 * t) + 64u * (db ^ q4) + 16u * ((2 * blk + (p4 >> 1)) ^ (hf + 2 * t)) + 8u * (p4 & 1); }
#pragma unroll 1
    for (int t = 0; t < 5; ++t) {
        const int kb = __builtin_amdgcn_readfirstlane((t + 5 - rot) % 5), kbn = __builtin_amdgcn_readfirstlane((t + 6 - rot) % 5);
        asm volatile("s_waitcnt vmcnt(8)" ::: "memory");
        f32x16 S;
#pragma unroll
        for (int i = 0; i < 16; ++i) S[i] = 0.f;
#pragma unroll
        for (int kk = 0; kk < 8; ++kk) { const bf16x8 kfr = *(const LAS bf16x8*)(kimg + voff_b(l31, 2 * kk + hf)); S = __builtin_amdgcn_mfma_f32_32x32x16_bf16(kfr, qf[kk], S, 0, 0, 0); }
        asm volatile("s_waitcnt lgkmcnt(0)" ::: "memory");
        if (t < 4) ATT_DMA_ANY(J0 - 64 + 32 * kbn, C_K, kimg);
        if (t < 4) { ATT_SOFTMAX_PV(kb, vimg, asm volatile("s_waitcnt vmcnt(8)" ::: "memory")); }
        else       { ATT_SOFTMAX_PV(kb, vimg, asm volatile("s_waitcnt vmcnt(0)" ::: "memory")); }
        asm volatile("s_waitcnt lgkmcnt(0)" ::: "memory");
        if (t < 4) ATT_DMA_ANY(J0 - 64 + 32 * kbn, C_V, vimg);
    }
    const float ltot = lsum + __shfl_xor(lsum, 32);
    const float inv = 1.0f / ltot;
    const int ql = r + dd * (J0 + l31) - P0;
    bf16* op = Oscr + (size_t)ql * 128 + 4 * hf;
#pragma unroll
    for (int db = 0; db < 4; ++db)
#pragma unroll
        for (int g4 = 0; g4 < 4; ++g4) { v2u w; w.x = cvtpk(O[db][4 * g4 + 0] * inv, O[db][4 * g4 + 1] * inv); w.y = cvtpk(O[db][4 * g4 + 2] * inv, O[db][4 * g4 + 3] * inv);
            *(v2u*)(op + 32 * db + 8 * g4) = w; }
    if (hf == 0) lse_scr[ql] = mrun + __builtin_amdgcn_logf(ltot);
}

__device__ __forceinline__ void attn_item(const Args& a, int h, int blk512, LAS unsigned char* lds, int tid_in, int wave, int lane_in) {
    int tid = tid_in; asm volatile("" : "+v"(tid)); int lane = tid & 63; (void)lane_in;
    unsigned char* ws = a.ws; const bf16* PROJ = (const bf16*)(ws + WS_R1); bf16* MG = (bf16*)(ws + WS_H);
    bf16* Oscr = (bf16*)(ws + WS_MIX) + (size_t)blockIdx.x * (3 * 512 * 128);
    float* lse = (float*)(ws + WS_LSE) + (size_t)blockIdx.x * (3 * 512);
    const int row0 = blk512 * 512;
    const int seq_base = row0 < T_P ? 0 : T_P, S = row0 < T_P ? T_P : T_S, P0 = row0 - seq_base;
    LAS unsigned char* vl = lds + wave * 16384;
#pragma unroll 1
    for (int p = 0; p < 3; ++p) {
        const int dd = p == 0 ? 1 : (p == 1 ? 4 : 16), tpr = 16 / dd, L = S / dd;
#pragma unroll 1
        for (int tt = 0; tt < 2; ++tt) {
            const int tau = wave + 8 * tt, r = tau / tpr, w = tau % tpr;
            attn_wave_tile(PROJ, seq_base, L, dd, r, P0 / dd + 32 * w, h, vl, Oscr + (size_t)p * 512 * 128, lse + p * 512, P0, lane, w % 5);
        }
    }
    __syncthreads();
    asm volatile("" : "+v"(lane));
    float* ssB = (float*)(ws + WS_SSB) + (size_t)h * T;
#pragma unroll 4
    for (int st = 0; st < 16; ++st) {
        const int pl = st * 32 + wave * 4 + (lane >> 4), ch = lane & 15;
        const float l0 = lse[pl], l1 = lse[512 + pl], l2 = lse[1024 + pl];
        const float mx = fmaxf(l0, fmaxf(l1, l2));
        float w0 = __builtin_amdgcn_exp2f(l0 - mx), w1 = __builtin_amdgcn_exp2f(l1 - mx), w2 = __builtin_amdgcn_exp2f(l2 - mx);
        const float iw = 1.0f / (w0 + w1 + w2); w0 *= iw; w1 *= iw; w2 *= iw;
        const v4u a0 = *(const v4u*)(Oscr + (size_t)pl * 128 + 8 * ch), a1 = *(const v4u*)(Oscr + (size_t)(512 + pl) * 128 + 8 * ch), a2 = *(const v4u*)(Oscr + (size_t)(1024 + pl) * 128 + 8 * ch);
        float o[8];
        o[0] = w0 * bflo(a0.x) + w1 * bflo(a1.x) + w2 * bflo(a2.x); o[1] = w0 * bfhi(a0.x) + w1 * bfhi(a1.x) + w2 * bfhi(a2.x);
        o[2] = w0 * bflo(a0.y) + w1 * bflo(a1.y) + w2 * bflo(a2.y); o[3] = w0 * bfhi(a0.y) + w1 * bfhi(a1.y) + w2 * bfhi(a2.y);
        o[4] = w0 * bflo(a0.z) + w1 * bflo(a1.z) + w2 * bflo(a2.z); o[5] = w0 * bfhi(a0.z) + w1 * bfhi(a1.z) + w2 * bfhi(a2.z);
        o[6] = w0 * bflo(a0.w) + w1 * bflo(a1.w) + w2 * bflo(a2.w); o[7] = w0 * bfhi(a0.w) + w1 * bfhi(a1.w) + w2 * bfhi(a2.w);
        float ss = 0.f;
#pragma unroll
        for (int i = 0; i < 8; ++i) ss += o[i] * o[i];
        ss += __shfl_xor(ss, 1); ss += __shfl_xor(ss, 2); ss += __shfl_xor(ss, 4); ss += __shfl_xor(ss, 8);
        v4u ow; ow.x = cvtpk(o[0], o[1]); ow.y = cvtpk(o[2], o[3]); ow.z = cvtpk(o[4], o[5]); ow.w = cvtpk(o[6], o[7]);
        *(v4u*)(MG + (size_t)(row0 + pl) * D + 1024 + h * 128 + 8 * ch) = ow;
        if (ch == 0) ssB[row0 + pl] = ss;
    }
    __syncthreads();
}

#define XB_TMO      128
#define XB_XCNT(j)  (256  + 64 * (j))
#define XB_XSUB(j)  (1280 + 64 * (j))
#define XB_XGEN(j)  (2304 + 64 * (j))
#define XB_TOP      3328
#define XB_TOPGEN   3392
#define XCD_BAR_WORDS 3456
#define XB_SPIN_CAP (1u << 18)

__device__ __forceinline__ unsigned xb_ld(unsigned* p)              { return __hip_atomic_load(p, __ATOMIC_RELAXED, __HIP_MEMORY_SCOPE_AGENT); }
__device__ __forceinline__ unsigned xb_add(unsigned* p, unsigned v) { return __hip_atomic_fetch_add(p, v, __ATOMIC_RELAXED, __HIP_MEMORY_SCOPE_AGENT); }
__device__ __forceinline__ unsigned xb_xcc_id() { return (unsigned)__builtin_amdgcn_s_getreg((3 << 11) | 20) & 0xFu; }
#define XB_SPIN(cond, bar) do { unsigned _sp = 0; while (cond) { __builtin_amdgcn_s_sleep(1); \
    if ((++_sp & 255u) == 0u) { if (xb_ld(&(bar)[XB_TMO])) break; if (_sp > XB_SPIN_CAP) { atomicAdd(&(bar)[XB_TMO], 1u); break; } } } } while (0)

struct XcdBarrier {
    unsigned* bar; unsigned x;
    volatile LAS unsigned* st;
};

__device__ __forceinline__ XcdBarrier xcd_barrier_post(unsigned* bar, volatile LAS unsigned* st, int wave_s) {
    XcdBarrier b; b.bar = bar; b.x = xb_xcc_id(); b.st = st;
    if (wave_s == 0 && fresh_lane() == 0) (void)xb_add(&bar[XB_XCNT(b.x)], 1u);
    return b;
}
__device__ __forceinline__ void xcd_barrier_complete(unsigned* bar, unsigned x, unsigned& nloc, unsigned& nx) {
    const unsigned G = gridDim.x * gridDim.y * gridDim.z;
    unsigned sum, cnt, mine, sp = 0u;
    for (;;) {
        sum = 0u; cnt = 0u; mine = 0u;
#pragma unroll
        for (unsigned j = 0; j < 16; ++j) { const unsigned c = xb_ld(&bar[XB_XCNT(j)]); sum += c; cnt += (c > 0u) ? 1u : 0u; mine = (j == x) ? c : mine; }
        if (sum == G) break;
        __builtin_amdgcn_s_sleep(1);
        if ((++sp & 255u) == 0u) { if (xb_ld(&bar[XB_TMO])) break; if (sp > XB_SPIN_CAP) { atomicAdd(&bar[XB_TMO], 1u); break; } }
    }
    nloc = mine > 0u ? mine : 1u; nx = cnt > 0u ? cnt : 1u;
}

__device__ __forceinline__ void xcd_barrier(const XcdBarrier& b, int wave_s) {
    asm volatile("s_waitcnt vmcnt(0)" ::: "memory");
    __syncthreads();
    if (wave_s == 0 && fresh_lane() == 0) {
        unsigned* bar = b.bar;
        __builtin_amdgcn_s_waitcnt(0);
        unsigned nloc = b.st[0], nx = b.st[1];
        if (nloc == 0u) { xcd_barrier_complete(bar, b.x, nloc, nx); b.st[0] = nloc; b.st[1] = nx; }
        const unsigned old = xb_add(&bar[XB_XSUB(b.x)], 1u);
        const unsigned gen = old / nloc;
        if (old + 1u == (gen + 1u) * nloc) {
            __builtin_amdgcn_fence(__ATOMIC_RELEASE, "agent");
            asm volatile("s_waitcnt vmcnt(0)" ::: "memory");
            const unsigned og = xb_add(&bar[XB_TOP], 1u);
            const unsigned tg = og / nx;
            if (og + 1u == (tg + 1u) * nx) xb_add(&bar[XB_TOPGEN], 1u);
            else XB_SPIN(xb_ld(&bar[XB_TOPGEN]) == tg, bar);
            __builtin_amdgcn_fence(__ATOMIC_ACQUIRE, "agent");
            xb_add(&bar[XB_XGEN(b.x)], 1u);
            asm volatile("s_waitcnt vmcnt(0)" ::: "memory");
        } else {
            XB_SPIN(xb_ld(&bar[XB_XGEN(b.x)]) == gen, bar);
            __builtin_amdgcn_fence(__ATOMIC_ACQUIRE, "agent");
            asm volatile("s_waitcnt vmcnt(0)" ::: "memory");
        }
    }
    __syncthreads();
}

__global__ void __launch_bounds__(NTHREADS, 2) fwd_megakernel(Args a) {
    extern __shared__ __attribute__((aligned(16))) unsigned char lds_raw[];
    LAS unsigned char* lds = (LAS unsigned char*)lds_raw;
    cg::grid_group grid = cg::this_grid();
#define PHASE_IDS() int tid = fresh_tid(wave_s); asm volatile("" : "+v"(tid)); const int lane = tid & 63, wave = __builtin_amdgcn_readfirstlane(tid >> 6); \
    int bid = blockIdx.x; asm volatile("" : "+s"(bid)); const int gw = bid * NWAVES + wave, NGW = G * NWAVES; (void)lane; (void)gw; (void)NGW;
    const int G = gridDim.x;
    const int wave_s = __builtin_amdgcn_readfirstlane(threadIdx.x >> 6);
    unsigned char* ws = a.ws;
    const float* rope = (const float*)(ws + WS_ROPE);
    {
        volatile LAS unsigned* misc0 = (volatile LAS unsigned*)(lds + MISC_OFF);
        if (threadIdx.x < 16) misc0[threadIdx.x] = 0u;
        if (blockIdx.x == 0) for (int i = threadIdx.x; i < 4096; i += NTHREADS) ((unsigned*)(ws + WS_CTL))[i] = 0u;
        __syncthreads();
    }

    for (int rep = 0; rep < REP_PRO; ++rep) { PHASE_IDS(); prologue_phase(a, lds, gw, NGW, wave, lane); }
    { PHASE_IDS(); resnorm_phase<true, false>(a, nullptr, a.in[2], gw, NGW, lane); }
    grid.sync();
    const XcdBarrier bar = xcd_barrier_post((unsigned*)(ws + WS_CTL), (volatile LAS unsigned*)(lds + MISC_OFF), wave_s);

#pragma unroll 1
    for (int l = 0; l < DEPTH; ++l) {
        {
            pg8::Gemm g{(const bf16*)(ws + WS_H), (const bf16*)(ws + WS_WIN) + (size_t)l * PW * D, T, PW, D};
            pg8::StaticOrder S; S.init(T, PW, G, (int)blockIdx.x);
            pg8::EpiProj E{(bf16*)(ws + WS_R1), rope, QSCALE};

            for (int rep = 0; rep < REP_GEMM; ++rep) { pg8::gemm_phase<pg8::EpiProj, pg8::StaticOrder, true, true>(lds, g, S, E, wave_s); }
        }
        xcd_barrier(bar, wave_s);
        {
            constexpr int N_ATT = 8 * (T / 512), N_GM = 8 * (T / 128);
            PHASE_IDS(); (void)bid;
            unsigned* qhead = (unsigned*)(ws + WS_CTL) + 3584 + 64 * l;
            volatile LAS int* slot = (volatile LAS int*)(lds + MISC_OFF + 64);
            if (tid == 0) *slot = (int)__hip_atomic_fetch_add(qhead, 1u, __ATOMIC_RELAXED, __HIP_MEMORY_SCOPE_AGENT);
            __syncthreads();
            int it = *slot;
            while (it < N_ATT + N_GM) {
                __syncthreads();
                if (tid == 0) *slot = (int)__hip_atomic_fetch_add(qhead, 1u, __ATOMIC_RELAXED, __HIP_MEMORY_SCOPE_AGENT);
                if (it < N_ATT) attn_item(a, it & 7, it >> 3, lds, tid, wave, lane);
                else { const int j = it - N_ATT; gmlp_item(a, l, j >> 3, j & 7, lds, tid, wave, lane); }
                __syncthreads();
                it = *slot;
            }
        }
        xcd_barrier(bar, wave_s);
        {
            pg8::Gemm g{(const bf16*)(ws + WS_H), (const bf16*)(ws + WS_WO) + (size_t)l * D * D, T, D, D};
            pg8::StaticOrder S; S.init(T, D, G, (int)blockIdx.x);
            pg8::EpiMixKS E{(bf16*)(ws + WS_MIX), (float*)(ws + WS_SSM), (const float*)(ws + WS_SSA), (const float*)(ws + WS_SSB), (LAS float*)(lds + 131072), T};
            for (int rep = 0; rep < REP_GEMM; ++rep) { pg8::gemm_phase<pg8::EpiMixKS, pg8::StaticOrder, true, true>(lds, g, S, E, wave_s); }
        }
        xcd_barrier(bar, wave_s);
        { PHASE_IDS(); resnorm_phase<false, false>(a, a.in[10] + (size_t)l * D, a.in[11] + (size_t)l * D, gw, NGW, lane); }
        xcd_barrier(bar, wave_s);
        {
            pg8::Gemm g{(const bf16*)(ws + WS_H), (const bf16*)(ws + WS_WGU) + (size_t)l * 2 * FF * D, T, 2 * FF, D};
            pg8::StaticOrder S; S.init(T, 2 * FF, G, (int)blockIdx.x);
            pg8::EpiGU E{(bf16*)(ws + WS_R1)};

            for (int rep = 0; rep < REP_GEMM; ++rep) { pg8::gemm_phase<pg8::EpiGU, pg8::StaticOrder, true, true>(lds, g, S, E, wave_s); }
        }
        xcd_barrier(bar, wave_s);
        {
            pg8::Gemm g{(const bf16*)(ws + WS_R1), (const bf16*)(ws + WS_WDN) + (size_t)l * D * FF, T, D, FF};
            pg8::StaticOrder S; S.init(T, D, G, (int)blockIdx.x);
            pg8::EpiMix E{(bf16*)(ws + WS_MIX), (float*)(ws + WS_SSM)};

            for (int rep = 0; rep < REP_GEMM; ++rep) { pg8::gemm_phase<pg8::EpiMix, pg8::StaticOrder, true, true>(lds, g, S, E, wave_s); }
        }
        xcd_barrier(bar, wave_s);
        if (l + 1 < DEPTH) { { PHASE_IDS(); resnorm_phase<false, false>(a, a.in[15] + (size_t)l * D, a.in[2] + (size_t)(l + 1) * D, gw, NGW, lane); } xcd_barrier(bar, wave_s); }
        else { PHASE_IDS(); resnorm_phase<false, true>(a, a.in[15] + (size_t)l * D, nullptr, gw, NGW, lane); }
    }
}

extern "C" void kernel_launch(void* const* d_in, const int* in_sizes, int n_in, void* d_out, int out_size, void* d_ws, size_t ws_size, hipStream_t stream) {
    static int grid = 0;
    if (grid == 0) {
        if (n_in != 16 || out_size != T * D || ws_size < WS_END) { fprintf(stderr, "kernel_launch: unexpected shapes (n_in %d, out %d, ws %zu); nothing launched\n", n_in, out_size, ws_size); grid = -1; return; }
        int dev = 0, cus = 0, per_cu = 0;
        hipGetDevice(&dev); hipDeviceGetAttribute(&cus, hipDeviceAttributeMultiprocessorCount, dev);
        if (hipFuncSetAttribute((const void*)fwd_megakernel, hipFuncAttributeMaxDynamicSharedMemorySize, LDS_BYTES) != hipSuccess) { fprintf(stderr, "kernel_launch: hipFuncSetAttribute failed\n"); grid = -1; return; }
        if (hipOccupancyMaxActiveBlocksPerMultiprocessor(&per_cu, (const void*)fwd_megakernel, NTHREADS, LDS_BYTES) != hipSuccess || per_cu < 1) { fprintf(stderr, "kernel_launch: occupancy query says %d\n", per_cu); per_cu = 1; }
        (void)hipGetLastError();
        grid = cus * (per_cu > 1 ? 1 : per_cu);
        if (grid <= 0) grid = 256;
    }
    if (grid < 0) return;
    Args a{};
    for (int i = 0; i < 16; ++i) a.in[i] = (const float*)d_in[i];
    a.out = (float*)d_out; a.ws = (unsigned char*)d_ws;
    void* args[] = {&a};
    hipError_t e = hipLaunchCooperativeKernel((const void*)fwd_megakernel, dim3(grid), dim3(NTHREADS), args, LDS_BYTES, stream);
    if (e != hipSuccess) fprintf(stderr, "kernel_launch: cooperative launch failed: %s (grid %d)\n", hipGetErrorString(e), grid);
}
```

```cpp
#include <hip/hip_runtime.h>
#include <hip/hip_cooperative_groups.h>
#include <cstdio>
#include <cstdint>
namespace cg = cooperative_groups;
#ifndef REP_GEMM
#define REP_GEMM 1
#endif
#ifndef REP_MIX
#define REP_MIX 1
#endif
#ifndef REP_ATT
#define REP_ATT 1
#endif
#ifndef REP_PRO
#define REP_PRO 1
#endif
__device__ __forceinline__ int fresh_lane() { int l; asm volatile("v_mbcnt_lo_u32_b32 %0, -1, 0\n\tv_mbcnt_hi_u32_b32 %0, -1, %0" : "=v"(l)); return l; }
__device__ __forceinline__ int fresh_tid(int wave_s) { return wave_s * 64 + fresh_lane(); }
namespace pg8 {
#define PG8_LAS __attribute__((address_space(3)))
typedef unsigned short bf16_t;
typedef short bf16x8 __attribute__((ext_vector_type(8)));
typedef float f32x4 __attribute__((ext_vector_type(4)));
typedef unsigned u32x4 __attribute__((ext_vector_type(4)));
constexpr int BM = 256, BK = 64, HALF = 128, HTB = HALF * BK * 2  , STAGE_BYTES = 8 * HTB, NXCD = 8, WGM = 8;

__host__ __device__ __forceinline__ int lds_byte(int r, int c) { const int st = (r >> 4) * 2 + (c >> 5), rr = r & 15, cc = c & 31, ob = rr * 64 + cc * 2; return st * 1024 + (ob ^ (((ob >> 9) & 1) << 5)); }
__host__ __device__ __forceinline__ void stage_rc(int b, int& R, int& C) { const int st = b / 1024, sb = b % 1024, swz = sb ^ (((sb >> 9) & 1) << 5); R = (st >> 1) * 16 + swz / 64; C = (st & 1) * 32 + (swz % 64) / 2; }
__host__ __device__ __forceinline__ int perm32(int rho) { const int n = rho >> 4, i = rho & 15; return 8 * (i >> 2) + 4 * n + (i & 3); }

struct Unit { int pm, pn; };
struct Gemm { const bf16_t* A; const bf16_t* Bt; int M, N, K; };

struct StaticOrder {
    int nM, nN, nwg, G, c;
    __host__ __device__ void init(int M, int N, int G_, int c_) { nM = M / BM; nN = N / BM; nwg = nM * nN; G = G_; c = c_; }
    __host__ __device__ bool next(int i, Unit& u) const {
        const long L = (long)i * G + c; if (L >= nwg) return false;
        int wgid = (int)L; { const int q = nwg / NXCD, r = nwg % NXCD, xcd = wgid % NXCD, off = wgid / NXCD; wgid = (xcd < r ? xcd * (q + 1) : r * (q + 1) + (xcd - r) * q) + off; }
        const int nig = WGM * nN, gid = wgid / nig, fm = gid * WGM, gsz = (nM - fm) < WGM ? (nM - fm) : WGM;
        u.pm = fm + ((wgid % nig) % gsz); u.pn = (wgid % nig) / gsz; return true;
    }
    __device__ __forceinline__ void a_ready(const Unit&) const {}
    __device__ __forceinline__ void done(const Unit&) const {}
};
__device__ __forceinline__ unsigned cvt_pk_bf16(float lo, float hi) { unsigned r; asm volatile("v_cvt_pk_bf16_f32 %0, %1, %2" : "=v"(r) : "v"(lo), "v"(hi)); return r; }
typedef float f32x2 __attribute__((ext_vector_type(2)));
__device__ __forceinline__ float fast_sigmoid(float t) { return __builtin_amdgcn_rcpf(1.0f + __builtin_amdgcn_exp2f(-1.44269504089f * t)); }
__device__ __forceinline__ float gelu_tanh(float x) { const float t = 1.5957691216057308f * (x + 0.044715f * x * x * x); return x * fast_sigmoid(t); }
__device__ __forceinline__ float silu_f(float x) { return x * fast_sigmoid(x); }
typedef unsigned u32x2 __attribute__((ext_vector_type(2)));

struct EpiProj {
    static constexpr bool PERM = false, AFTER_DRAIN = false, KSPLIT = false;
    bf16_t* O; const float* rope; float qscale;
    __device__ __forceinline__ void operator()(const f32x4 (&acc)[2][2][4][2], const Unit& u, int wr, int wc, int fr, int fq) const {
        const int row0 = u.pm * BM + wr * 64 + fr, col0 = u.pn * BM + wc * 32 + 4 * fq;
        const int kind = u.pn >> 2;
        const bool do_rope = (kind == 2 || kind == 3) && (wc == 0);
#pragma unroll
        for (int ai = 0; ai < 2; ++ai)
#pragma unroll
            for (int m = 0; m < 4; ++m) {
                const int row = row0 + ai * HALF + m * 16;
                const int pos = row < 8192 ? row : row - 8192;
                bf16_t* rowp = O + (size_t)row * 5120 + col0;
                f32x4 cs = (f32x4){1.f, 1.f, 1.f, 1.f}, sn = (f32x4){0.f, 0.f, 0.f, 0.f};
                if (do_rope) { cs = *(const f32x4*)(rope + pos * 32 + 4 * fq); sn = *(const f32x4*)(rope + pos * 32 + 16 + 4 * fq); }
#pragma unroll
                for (int bj = 0; bj < 2; ++bj) {
                    f32x4 v0 = acc[ai][bj][m][0], v1 = acc[ai][bj][m][1];
                    if (kind < 2) {
#pragma unroll
                        for (int j = 0; j < 4; ++j) { v0[j] = gelu_tanh(v0[j]); v1[j] = gelu_tanh(v1[j]); }
                    } else if (do_rope) {
                        const f32x4 o0 = v0 * cs - v1 * sn, o1 = v1 * cs + v0 * sn; v0 = o0; v1 = o1;
                    }
                    if (kind == 2) { v0 = v0 * qscale; v1 = v1 * qscale; }
                    u32x2 w0, w1; w0.x = cvt_pk_bf16(v0[0], v0[1]); w0.y = cvt_pk_bf16(v0[2], v0[3]); w1.x = cvt_pk_bf16(v1[0], v1[1]); w1.y = cvt_pk_bf16(v1[2], v1[3]);
                    *(u32x2*)(rowp + bj * HALF) = w0; *(u32x2*)(rowp + bj * HALF + 16) = w1;
                }
            }
    }
};
struct EpiGU {
    static constexpr bool PERM = true, AFTER_DRAIN = false, KSPLIT = false;
    bf16_t* O;
    __device__ __forceinline__ void operator()(const f32x4 (&acc)[2][2][4][2], const Unit& u, int wr, int wc, int fr, int fq) const {
        const int row0 = u.pm * BM + wr * 64 + fr, col0 = u.pn * HALF + wc * 32 + 8 * fq;
#pragma unroll
        for (int ai = 0; ai < 2; ++ai)
#pragma unroll
            for (int m = 0; m < 4; ++m) {
                bf16_t* rowp = O + (size_t)(row0 + ai * HALF + m * 16) * 5632 + col0;
                f32x4 r0, r1;
#pragma unroll
                for (int j = 0; j < 4; ++j) { r0[j] = silu_f(acc[ai][0][m][0][j]) * acc[ai][1][m][0][j]; r1[j] = silu_f(acc[ai][0][m][1][j]) * acc[ai][1][m][1][j]; }
                u32x4 w; w.x = cvt_pk_bf16(r0[0], r0[1]); w.y = cvt_pk_bf16(r0[2], r0[3]); w.z = cvt_pk_bf16(r1[0], r1[1]); w.w = cvt_pk_bf16(r1[2], r1[3]);
                *(u32x4*)rowp = w;
            }
    }
};
struct EpiMix {
    static constexpr bool PERM = true, AFTER_DRAIN = false, KSPLIT = false;
    bf16_t* O; float* ss;
    __device__ __forceinline__ void operator()(const f32x4 (&acc)[2][2][4][2], const Unit& u, int wr, int wc, int fr, int fq) const {
        const int row0 = u.pm * BM + wr * 64 + fr, col0 = u.pn * BM + wc * 32 + 8 * fq;
#pragma unroll
        for (int ai = 0; ai < 2; ++ai)
#pragma unroll
            for (int m = 0; m < 4; ++m) {
                const int row = row0 + ai * HALF + m * 16;
                bf16_t* rowp = O + (size_t)row * 2048 + col0;
                float s = 0.f;
#pragma unroll
                for (int bj = 0; bj < 2; ++bj) {
                    const f32x4 v0 = acc[ai][bj][m][0], v1 = acc[ai][bj][m][1];
                    s += (v0[0] * v0[0] + v0[1] * v0[1]) + (v0[2] * v0[2] + v0[3] * v0[3]) + (v1[0] * v1[0] + v1[1] * v1[1]) + (v1[2] * v1[2] + v1[3] * v1[3]);
                    u32x4 w; w.x = cvt_pk_bf16(v0[0], v0[1]); w.y = cvt_pk_bf16(v0[2], v0[3]); w.z = cvt_pk_bf16(v1[0], v1[1]); w.w = cvt_pk_bf16(v1[2], v1[3]);
                    *(u32x4*)(rowp + bj * HALF) = w;
                }
                s += __shfl_xor(s, 16); s += __shfl_xor(s, 32);
                if (fq == 0) ss[(size_t)row * 32 + u.pn * 4 + wc] = s;
            }
    }
};

struct EpiMixKS {
    static constexpr bool PERM = true, AFTER_DRAIN = false, KSPLIT = true;
    bf16_t* O; float* ss; const float* ssA; const float* ssB; PG8_LAS float* tbl; int Trows;
    __device__ __forceinline__ void prep(const Unit& u, int ui, int tid) const {
        if (tid < 256) {
            const int row = u.pm * BM + tid; float sa = 0.f, sb = 0.f;
#pragma unroll
            for (int g = 0; g < 8; ++g) { sa += ssA[(size_t)g * Trows + row]; sb += ssB[(size_t)g * Trows + row]; }
            const float rA = 1.0f / sqrtf(sa * (1.0f / 1024.0f) + 1e-6f), rB = 1.0f / sqrtf(sb * (1.0f / 1024.0f) + 1e-6f);
            tbl[(ui & 1) * 512 + tid * 2 + 0] = rA / rB; tbl[(ui & 1) * 512 + tid * 2 + 1] = rB;
        }
    }
    __device__ __forceinline__ void mid(f32x4 (&acc)[2][2][4][2], int ui, int wr, int fr) const {
#pragma unroll
        for (int ai = 0; ai < 2; ++ai)
#pragma unroll
            for (int m = 0; m < 4; ++m) { const float sc = tbl[(ui & 1) * 512 + (ai * HALF + wr * 64 + m * 16 + fr) * 2];
#pragma unroll
                for (int bj = 0; bj < 2; ++bj)
#pragma unroll
                    for (int n = 0; n < 2; ++n) acc[ai][bj][m][n] = acc[ai][bj][m][n] * sc; }
    }
    __device__ __forceinline__ void epi_ks(const f32x4 (&acc)[2][2][4][2], const Unit& u, int ui, int wr, int wc, int fr, int fq) const {
        const int row0 = u.pm * BM + wr * 64 + fr, col0 = u.pn * BM + wc * 32 + 8 * fq;
#pragma unroll
        for (int ai = 0; ai < 2; ++ai)
#pragma unroll
            for (int m = 0; m < 4; ++m) {
                const int row = row0 + ai * HALF + m * 16;
                const float sc = tbl[(ui & 1) * 512 + (ai * HALF + wr * 64 + m * 16 + fr) * 2 + 1];
                bf16_t* rowp = O + (size_t)row * 2048 + col0;
                float s = 0.f;
#pragma unroll
                for (int bj = 0; bj < 2; ++bj) {
                    const f32x4 v0 = acc[ai][bj][m][0] * sc, v1 = acc[ai][bj][m][1] * sc;
                    s += (v0[0] * v0[0] + v0[1] * v0[1]) + (v0[2] * v0[2] + v0[3] * v0[3]) + (v1[0] * v1[0] + v1[1] * v1[1]) + (v1[2] * v1[2] + v1[3] * v1[3]);
                    u32x4 w; w.x = cvt_pk_bf16(v0[0], v0[1]); w.y = cvt_pk_bf16(v0[2], v0[3]); w.z = cvt_pk_bf16(v1[0], v1[1]); w.w = cvt_pk_bf16(v1[2], v1[3]);
                    *(u32x4*)(rowp + bj * HALF) = w;
                }
                s += __shfl_xor(s, 16); s += __shfl_xor(s, 32);
                if (fq == 0) ss[(size_t)row * 32 + u.pn * 4 + wc] = s;
            }
    }
    __device__ __forceinline__ void operator()(const f32x4 (&)[2][2][4][2], const Unit&, int, int, int, int) const {}
};

template <class Epi, class Sched, bool ALIGN_EPI = false, bool SP2 = false>
__device__ __forceinline__ void gemm_phase(PG8_LAS unsigned char* lds, const Gemm g, const Sched& S, const Epi& E, int wave_s) {
    int tid_ = fresh_tid(wave_s); asm volatile("" : "+v"(tid_));
    const int tid = tid_, wid = __builtin_amdgcn_readfirstlane(tid >> 6), lane = tid & 63, wr = wid >> 2, wc = wid & 3, fr = lane & 15, fq = lane >> 4;
    const int K = g.K, nt = K / BK;
    unsigned voffA[2], voffB[2];
#pragma unroll
    for (int i = 0; i < 2; ++i) { int R, C; stage_rc(tid * 16 + i * 8192, R, C); const int Rb = Epi::PERM ? ((R & ~31) + perm32(R & 31)) : R;
        voffA[i] = (unsigned)(R * K + C) * 2u; voffB[i] = (unsigned)(Rb * K + C) * 2u; }
    const size_t kstep = (size_t)(BK * 2);
    const size_t hstep = (size_t)HALF * K * 2;
    const size_t tstep = 2 * hstep;
    const unsigned ldsw = (unsigned)wid * 1024u;
    const int aoff = lds_byte(wr * 64 + fr, fq * 8), boff = lds_byte(wc * 32 + fr, fq * 8);
#define PG8_SA(b, h) (((b) * 2 + (h)) * HTB)
#define PG8_SB(b, h) ((4 + (b) * 2 + (h)) * HTB)
#define PG8_STAGE(bufoff, gbase, voff) do { _Pragma("unroll") for (int _i = 0; _i < 2; ++_i) \
        __builtin_amdgcn_global_load_lds((const unsigned*)((const char*)(gbase) + (voff)[_i]), (PG8_LAS unsigned*)(lds + (bufoff) + ldsw + _i * 8192), 16, 0, 0); } while (0)
#define PG8_LDA(dst, b, h) do { _Pragma("unroll") for (int m = 0; m < 4; ++m) _Pragma("unroll") for (int k = 0; k < 2; ++k) dst[m][k] = *(const PG8_LAS bf16x8*)(lds + PG8_SA(b, h) + aoff + m * 2048 + k * 1024); } while (0)
#define PG8_LDB(dst, b, h) do { _Pragma("unroll") for (int n = 0; n < 2; ++n) _Pragma("unroll") for (int k = 0; k < 2; ++k) dst[n][k] = *(const PG8_LAS bf16x8*)(lds + PG8_SB(b, h) + boff + n * 2048 + k * 1024); } while (0)
#define PG8_MMA(ai, bj, At, Bt) do { __builtin_amdgcn_s_setprio(1); _Pragma("unroll") for (int m = 0; m < 4; ++m) _Pragma("unroll") for (int n = 0; n < 2; ++n) _Pragma("unroll") for (int k = 0; k < 2; ++k) \
        acc[ai][bj][m][n] = __builtin_amdgcn_mfma_f32_16x16x32_bf16(Bt[n][k], At[m][k], acc[ai][bj][m][n], 0, 0, 0); __builtin_amdgcn_s_setprio(0); } while (0)
#define PG8_WAIT_V(n) asm volatile("s_waitcnt vmcnt(" #n ")" ::: "memory")
#define PG8_WAIT_L(n) asm volatile("s_waitcnt lgkmcnt(" #n ")" ::: "memory")
#define PG8_BAR __builtin_amdgcn_s_barrier()
#define PG8_SCHED __builtin_amdgcn_sched_barrier(0)
    Unit cur, nxt; int ui = 0;
    if (!S.next(0, cur)) return;
    if constexpr (Epi::KSPLIT) E.prep(cur, 0, tid);
    f32x4 acc[2][2][4][2];
#pragma unroll
    for (int a = 0; a < 2; ++a)
#pragma unroll
        for (int b = 0; b < 2; ++b)
#pragma unroll
            for (int m = 0; m < 4; ++m)
#pragma unroll
                for (int n = 0; n < 2; ++n) acc[a][b][m][n] = (f32x4){0.f, 0.f, 0.f, 0.f};
    bf16x8 At[4][2], B0[2][2], B1[2][2];
    const char* cA = (const char*)g.A + (size_t)cur.pm * tstep; const char* cB = (const char*)g.Bt + (size_t)cur.pn * tstep;
    S.a_ready(cur);
    if constexpr (SP2) {
        PG8_STAGE(PG8_SB(0, 0), cB, voffB); PG8_STAGE(PG8_SB(0, 1), cB + hstep, voffB); PG8_STAGE(PG8_SA(0, 0), cA, voffA); PG8_STAGE(PG8_SA(0, 1), cA + hstep, voffA);
        if (wr == 1) PG8_BAR;
        PG8_WAIT_V(2); PG8_BAR;
        PG8_STAGE(PG8_SB(1, 0), cB + kstep, voffB); PG8_STAGE(PG8_SA(1, 0), cA + kstep, voffA); PG8_STAGE(PG8_SB(1, 1), cB + hstep + kstep, voffB);
        PG8_WAIT_V(6); PG8_BAR;
    } else {
        PG8_STAGE(PG8_SB(0, 0), cB, voffB); PG8_STAGE(PG8_SA(0, 0), cA, voffA); PG8_STAGE(PG8_SB(0, 1), cB + hstep, voffB); PG8_STAGE(PG8_SA(0, 1), cA + hstep, voffA);
        if (wr == 1) PG8_BAR;
        PG8_WAIT_V(4); PG8_BAR;
        PG8_STAGE(PG8_SB(1, 0), cB + kstep, voffB); PG8_STAGE(PG8_SA(1, 0), cA + kstep, voffA); PG8_STAGE(PG8_SB(1, 1), cB + hstep + kstep, voffB);
        PG8_WAIT_V(6); PG8_BAR;
    }
    for (;;) {
        const bool has_next = S.next(ui + 1, nxt);
        const char* nA = has_next ? (const char*)g.A + (size_t)nxt.pm * tstep : cA; const char* nB = has_next ? (const char*)g.Bt + (size_t)nxt.pn * tstep : cB;
        for (int t = 0; t < nt; t += 2) {
            if constexpr (Epi::KSPLIT) { if (t == (nt >> 1)) E.mid(acc, ui, wr, fr); }
            const bool last = (t == nt - 2);
            const char* a1 = cA + (size_t)(t + 1) * kstep;
            const char* a2 = last ? nA : cA + (size_t)(t + 2) * kstep; const char* b2 = last ? nB : cB + (size_t)(t + 2) * kstep;
            const char* a3 = a2 + kstep; const char* b3 = b2 + kstep;
            if (last && has_next) S.a_ready(nxt);
            if constexpr (SP2) {
            PG8_LDB(B0, 0, 0); PG8_LDB(B1, 0, 1); PG8_SCHED; PG8_LDA(At, 0, 0); PG8_STAGE(PG8_SA(1, 1), a1 + hstep, voffA);
            PG8_WAIT_V(8); PG8_WAIT_L(0); PG8_BAR; PG8_MMA(0, 0, At, B0); PG8_MMA(0, 1, At, B1); PG8_BAR; PG8_SCHED;
            PG8_LDA(At, 0, 1); PG8_STAGE(PG8_SB(0, 0), b2, voffB); PG8_STAGE(PG8_SB(0, 1), b2 + hstep, voffB); PG8_STAGE(PG8_SA(0, 0), a2, voffA);
            PG8_WAIT_V(8); PG8_WAIT_L(0); PG8_BAR; PG8_MMA(1, 0, At, B0); PG8_MMA(1, 1, At, B1); PG8_BAR; PG8_SCHED;
            PG8_LDB(B0, 1, 0); PG8_LDB(B1, 1, 1); PG8_SCHED; PG8_LDA(At, 1, 0); PG8_STAGE(PG8_SA(0, 1), a2 + hstep, voffA);
            PG8_WAIT_V(8); PG8_WAIT_L(0); PG8_BAR; PG8_MMA(0, 0, At, B0); PG8_MMA(0, 1, At, B1); PG8_BAR; PG8_SCHED;
            PG8_LDA(At, 1, 1); PG8_STAGE(PG8_SB(1, 0), b3, voffB); PG8_STAGE(PG8_SB(1, 1), b3 + hstep, voffB); PG8_STAGE(PG8_SA(1, 0), a3, voffA);
            PG8_WAIT_V(8); PG8_WAIT_L(0); PG8_BAR; PG8_MMA(1, 0, At, B0); PG8_MMA(1, 1, At, B1); PG8_BAR; PG8_SCHED;
            } else {
            PG8_LDB(B0, 0, 0); PG8_SCHED; PG8_LDA(At, 0, 0); PG8_STAGE(PG8_SA(1, 1), a1 + hstep, voffA);
            PG8_WAIT_L(8); PG8_BAR; PG8_WAIT_L(0); PG8_MMA(0, 0, At, B0); PG8_BAR; PG8_SCHED;
            PG8_LDB(B1, 0, 1); PG8_STAGE(PG8_SB(0, 0), b2, voffB);
            PG8_BAR; PG8_WAIT_L(0); PG8_MMA(0, 1, At, B1); PG8_BAR;
            PG8_LDA(At, 0, 1); PG8_STAGE(PG8_SA(0, 0), a2, voffA);
            PG8_BAR; PG8_WAIT_L(0); PG8_MMA(1, 0, At, B0); PG8_BAR; PG8_SCHED;
            PG8_STAGE(PG8_SB(0, 1), b2 + hstep, voffB);
            PG8_WAIT_V(6); PG8_BAR; PG8_MMA(1, 1, At, B1); PG8_BAR;
            PG8_LDB(B0, 1, 0); PG8_SCHED; PG8_LDA(At, 1, 0); PG8_STAGE(PG8_SA(0, 1), a2 + hstep, voffA);
            PG8_WAIT_L(8); PG8_BAR; PG8_WAIT_L(0); PG8_MMA(0, 0, At, B0); PG8_BAR; PG8_SCHED;
            PG8_LDB(B1, 1, 1); PG8_STAGE(PG8_SB(1, 0), b3, voffB);
            PG8_BAR; PG8_WAIT_L(0); PG8_MMA(0, 1, At, B1); PG8_BAR;
            PG8_LDA(At, 1, 1); PG8_STAGE(PG8_SA(1, 0), a3, voffA);
            PG8_BAR; PG8_WAIT_L(0); PG8_MMA(1, 0, At, B0); PG8_BAR; PG8_SCHED;
            PG8_STAGE(PG8_SB(1, 1), b3 + hstep, voffB);
            PG8_WAIT_V(6); PG8_BAR; PG8_MMA(1, 1, At, B1); PG8_BAR;
            }
        }
        if constexpr (ALIGN_EPI) { if (wr == 0) PG8_BAR; }
        if constexpr (!Epi::AFTER_DRAIN) { if constexpr (Epi::KSPLIT) E.epi_ks(acc, cur, ui, wr, wc, fr, fq); else E(acc, cur, wr, wc, fr, fq); S.done(cur); }
        if (!has_next) break;
#pragma unroll
        for (int a = 0; a < 2; ++a)
#pragma unroll
            for (int b = 0; b < 2; ++b)
#pragma unroll
                for (int m = 0; m < 4; ++m)
#pragma unroll
                    for (int n = 0; n < 2; ++n) acc[a][b][m][n] = (f32x4){0.f, 0.f, 0.f, 0.f};
        cur = nxt; cA = nA; cB = nB; ++ui;
        if constexpr (Epi::KSPLIT) E.prep(cur, ui, tid);
        if constexpr (ALIGN_EPI) { if (wr == 1) PG8_BAR; }
    }
    PG8_WAIT_V(0);
    if constexpr (!ALIGN_EPI) { if (wr == 0) PG8_BAR; }
    PG8_BAR;
    if constexpr (Epi::AFTER_DRAIN) { E.fused(acc, cur, wr, wc, fr, fq, lds, wid, lane); S.done(cur); }
#undef PG8_SA
#undef PG8_SB
#undef PG8_STAGE
#undef PG8_LDA
#undef PG8_LDB
#undef PG8_MMA
#undef PG8_WAIT_V
#undef PG8_WAIT_L
#undef PG8_BAR
#undef PG8_SCHED
}
}
#define LAS __attribute__((address_space(3)))
typedef unsigned short bf16;
typedef float f32x4 __attribute__((ext_vector_type(4)));
typedef float f32x16 __attribute__((ext_vector_type(16)));
typedef short bf16x8 __attribute__((ext_vector_type(8)));
typedef short s16x4 __attribute__((ext_vector_type(4)));
typedef unsigned v4u __attribute__((ext_vector_type(4)));
typedef unsigned v2u __attribute__((ext_vector_type(2)));

constexpr int NWAVES = 8, NTHREADS = 512;
constexpr int T_P = 8192, T_S = 16384, T = T_P + T_S, D = 2048, PW = 5120, FF = 5632, DEPTH = 4;
constexpr int C_U = 0, C_VA = 1024, C_Q = 2048, C_K = 3072, C_V = 4096;
constexpr float EPS = 1e-6f;
constexpr float QSCALE = 0.08838834764831845f * 1.4426950408889634f;

constexpr size_t MiB = 1u << 20;
constexpr size_t WS_CTL = 0;
constexpr size_t WS_ROPE = 1 * MiB;
constexpr size_t WS_WSB = 3 * MiB;
constexpr size_t WS_SSA = 4 * MiB;
constexpr size_t WS_SSB = 5 * MiB;
constexpr size_t WS_SSM = 6 * MiB;
constexpr size_t WS_LSE = 9 * MiB;
constexpr size_t WS_WIN = 12 * MiB;
constexpr size_t WS_WO = 92 * MiB;
constexpr size_t WS_WGU = 124 * MiB;
constexpr size_t WS_WDN = 300 * MiB;
constexpr size_t WS_H = 388 * MiB;
constexpr size_t WS_R1 = 484 * MiB;
constexpr size_t WS_MIX = 748 * MiB;
constexpr size_t WS_X = 844 * MiB;
constexpr size_t WS_END = 940 * MiB;
constexpr int LDS_BYTES = 147456, MISC_OFF = 131072 + 12288;

__device__ __forceinline__ unsigned cvtpk(float lo, float hi) { unsigned r; asm volatile("v_cvt_pk_bf16_f32 %0, %1, %2" : "=v"(r) : "v"(lo), "v"(hi)); return r; }
__device__ __forceinline__ float bflo(unsigned w) { return __uint_as_float(w << 16); }
__device__ __forceinline__ float bfhi(unsigned w) { return __uint_as_float(w & 0xffff0000u); }
__device__ __forceinline__ float wave_sum(float v) {
#pragma unroll
    for (int o = 1; o < 64; o <<= 1) v += __shfl_xor(v, o);
    return v;
}

struct Args { const float* in[16]; float* out; unsigned char* ws; };

__device__ __forceinline__ void transpose_item(const float* W, int K, int N, bf16* WT, int mode, LAS float* scr, int item, int lane, const float* kscale = nullptr) {
    const int nblk = N / 32, kb = item / nblk, nb = item % nblk, k0 = 64 * kb, n0 = 32 * nb;
    const int drow0 = mode == 0 ? n0 : (256 * (n0 >> 7) + (n0 & 127) + (mode == 2 ? 128 : 0));
#pragma unroll 8
    for (int i = 0; i < 32; ++i) { const int kk = 2 * i + (lane >> 5); float w = W[(size_t)(k0 + kk) * N + n0 + (lane & 31)]; if (kscale) w *= kscale[k0 + kk]; scr[kk * 33 + (lane & 31)] = w; }
    asm volatile("s_waitcnt lgkmcnt(0)" ::: "memory");
    const int c = lane & 7;
#pragma unroll
    for (int j = 0; j < 4; ++j) { const int n = (lane >> 3) + 8 * j; const LAS float* s = scr + (8 * c) * 33 + n;
        v4u o; o.x = cvtpk(s[0 * 33], s[1 * 33]); o.y = cvtpk(s[2 * 33], s[3 * 33]); o.z = cvtpk(s[4 * 33], s[5 * 33]); o.w = cvtpk(s[6 * 33], s[7 * 33]);
        *(v4u*)(WT + (size_t)(drow0 + n) * K + k0 + 8 * c) = o; }
    asm volatile("s_waitcnt lgkmcnt(0)" ::: "memory");
}

__device__ __forceinline__ void prologue_phase(const Args& a, LAS unsigned char* lds, int gw, int NGW, int wave, int lane) {
    unsigned char* ws = a.ws;
    LAS float* scr = (LAS float*)(lds + wave * 16384);
    constexpr int I_IN = (D / 64) * (PW / 32), I_O = (D / 64) * (D / 32), I_G = (D / 64) * (FF / 32), I_D = (FF / 64) * (D / 32);
    constexpr int PER_L = I_IN + I_O + 2 * I_G + I_D;
    for (int it = gw; it < DEPTH * PER_L; it += NGW) {
        const int l = it / PER_L; int r = it % PER_L;
        if (r < I_IN) { transpose_item(a.in[3] + (size_t)l * D * PW, D, PW, (bf16*)(ws + WS_WIN) + (size_t)l * PW * D, 0, scr, r, lane); continue; } r -= I_IN;
        if (r < I_O) { const int kb_ = r / (D / 32);
            const float* ks = (kb_ < 16 ? a.in[7] + (size_t)l * 1024 : a.in[8] + (size_t)l * 1024 - 1024);
            transpose_item(a.in[9] + (size_t)l * D * D, D, D, (bf16*)(ws + WS_WO) + (size_t)l * D * D, 0, scr, r, lane, ks); continue; } r -= I_O;
        if (r < I_G) { transpose_item(a.in[12] + (size_t)l * D * FF, D, FF, (bf16*)(ws + WS_WGU) + (size_t)l * 2 * FF * D, 1, scr, r, lane); continue; } r -= I_G;
        if (r < I_G) { transpose_item(a.in[13] + (size_t)l * D * FF, D, FF, (bf16*)(ws + WS_WGU) + (size_t)l * 2 * FF * D, 2, scr, r, lane); continue; } r -= I_G;
        transpose_item(a.in[14] + (size_t)l * FF * D, FF, D, (bf16*)(ws + WS_WDN) + (size_t)l * D * FF, 0, scr, r, lane);
    }
    { const float* src = a.in[5]; bf16* dst = (bf16*)(ws + WS_WSB); const int n4 = DEPTH * 8 * 128 * 128 / 4;
      for (int i = gw * 64 + lane; i < n4; i += NGW * 64) { const f32x4 v = ((const f32x4*)src)[i]; v2u o; o.x = cvtpk(v[0], v[1]); o.y = cvtpk(v[2], v[3]); ((v2u*)dst)[i] = o; } }
    { float* tab = (float*)(ws + WS_ROPE);
      for (int i = gw * 64 + lane; i < 16384 * 16; i += NGW * 64) { const int pos = i >> 4, f = i & 15;
          const float inv = (float)pow(500000.0, -(double)f / 16.0); const float ang = (float)pos * inv;
          tab[pos * 32 + f] = (float)cos((double)ang); tab[pos * 32 + 16 + f] = (float)sin((double)ang); } }
}

template <bool FIRST, bool LAST>
__device__ __forceinline__ void resnorm_phase(const Args& a, const float* g_post, const float* g_next, int gw, int NGW, int lane) {
    unsigned char* ws = a.ws; bf16* X = (bf16*)(ws + WS_X); bf16* H = (bf16*)(ws + WS_H);
    const bf16* MIXb = (const bf16*)(ws + WS_MIX); const float* ssM = (const float*)(ws + WS_SSM);
    constexpr int R = FIRST ? 2 : 4;
    f32x4 gp[8], gn[8];
#pragma unroll
    for (int j = 0; j < 8; ++j) { gp[j] = FIRST ? (f32x4){0.f, 0.f, 0.f, 0.f} : ((const f32x4*)g_post)[lane + 64 * j]; gn[j] = LAST ? (f32x4){0.f, 0.f, 0.f, 0.f} : ((const f32x4*)g_next)[lane + 64 * j]; }
    for (int row0 = gw; row0 < T; row0 += R * NGW) {
        v2u xv[R][8], m[R][8]; f32x4 vin[FIRST ? R : 1][8]; float ssp[R];
#pragma unroll
        for (int q = 0; q < R; ++q) { const int row = row0 + q * NGW; if (row < T) {
            if (FIRST) {
                const f32x4* src = (const f32x4*)(row < T_P ? a.in[0] + (size_t)row * D : a.in[1] + (size_t)(row - T_P) * D);
#pragma unroll
                for (int j = 0; j < 8; ++j) vin[FIRST ? q : 0][j] = src[lane + 64 * j];
            } else {
                const v2u* xr = (const v2u*)(X + (size_t)row * D); const v2u* mp = (const v2u*)(MIXb + (size_t)row * D);
#pragma unroll
                for (int j = 0; j < 8; ++j) { xv[q][j] = xr[lane + 64 * j]; m[q][j] = mp[lane + 64 * j]; }
                ssp[q] = lane < 32 ? ssM[(size_t)row * 32 + lane] : 0.f;
            } } }
#pragma unroll
        for (int q = 0; q < R; ++q) { const int row = row0 + q * NGW; if (row < T) {
            f32x4 v[8];
            if (FIRST) {
#pragma unroll
                for (int j = 0; j < 8; ++j) v[j] = vin[FIRST ? q : 0][j];
            } else {
                const float rinv = 1.0f / sqrtf(wave_sum(ssp[q]) * (1.0f / D) + EPS);
#pragma unroll
                for (int j = 0; j < 8; ++j) {
                    v[j][0] = bflo(xv[q][j].x) + bflo(m[q][j].x) * rinv * gp[j][0]; v[j][1] = bfhi(xv[q][j].x) + bfhi(m[q][j].x) * rinv * gp[j][1];
                    v[j][2] = bflo(xv[q][j].y) + bflo(m[q][j].y) * rinv * gp[j][2]; v[j][3] = bfhi(xv[q][j].y) + bfhi(m[q][j].y) * rinv * gp[j][3]; }
            }
            if (LAST) {
                f32x4* yo = (f32x4*)(a.out + (size_t)row * D);
#pragma unroll
                for (int j = 0; j < 8; ++j) yo[lane + 64 * j] = v[j];
            } else {
                v2u* xo = (v2u*)(X + (size_t)row * D); v2u* ho = (v2u*)(H + (size_t)row * D); float s2 = 0.f;
#pragma unroll
                for (int j = 0; j < 8; ++j) { v2u o; o.x = cvtpk(v[j][0], v[j][1]); o.y = cvtpk(v[j][2], v[j][3]); xo[lane + 64 * j] = o;
                    s2 += (v[j][0] * v[j][0] + v[j][1] * v[j][1]) + (v[j][2] * v[j][2] + v[j][3] * v[j][3]); }
                const float r2 = 1.0f / sqrtf(wave_sum(s2) * (1.0f / D) + EPS);
#pragma unroll
                for (int j = 0; j < 8; ++j) { v2u o; o.x = cvtpk(v[j][0] * r2 * gn[j][0], v[j][1] * r2 * gn[j][1]); o.y = cvtpk(v[j][2] * r2 * gn[j][2], v[j][3] * r2 * gn[j][3]); ho[lane + 64 * j] = o; }
            } } }
    }
}

__device__ __forceinline__ void mnorm_phase(const Args& a, const float* gA, const float* gB, int gw, int NGW, int lane) {
    unsigned char* ws = a.ws; bf16* MG = (bf16*)(ws + WS_H); const float* ssA = (const float*)(ws + WS_SSA); const float* ssB = (const float*)(ws + WS_SSB);
    for (int row = gw; row < T; row += NGW) {
        float p = lane < 8 ? ssA[(size_t)lane * T + row] : (lane < 16 ? ssB[(size_t)(lane - 8) * T + row] : 0.f);
        p += __shfl_xor(p, 1); p += __shfl_xor(p, 2); p += __shfl_xor(p, 4);
        const float sa = __shfl(p, 0), sb = __shfl(p, 8);
        const float rA = 1.0f / sqrtf(sa * (1.0f / 1024.0f) + EPS), rB = 1.0f / sqrtf(sb * (1.0f / 1024.0f) + EPS);
        v4u* rp = (v4u*)(MG + (size_t)row * D);
#pragma unroll
        for (int j = 0; j < 4; ++j) {
            const int ch = lane + 64 * j; v4u w = rp[ch];
            const float r = j < 2 ? rA : rB; const float* g = (j < 2 ? gA : gB) + (ch & 127) * 8;
            const f32x4 g0 = *(const f32x4*)g, g1 = *(const f32x4*)(g + 4);
            v4u o; o.x = cvtpk(bflo(w.x) * r * g0[0], bfhi(w.x) * r * g0[1]); o.y = cvtpk(bflo(w.y) * r * g0[2], bfhi(w.y) * r * g0[3]);
            o.z = cvtpk(bflo(w.z) * r * g1[0], bfhi(w.z) * r * g1[1]); o.w = cvtpk(bflo(w.w) * r * g1[2], bfhi(w.w) * r * g1[3]);
            rp[ch] = o;
        }
    }
}

constexpr int GM_LDT = 136;
__device__ __forceinline__ void gmlp_item(const Args& a, int layer, int chunk, int g, LAS unsigned char* lds, int tid_in, int wave, int lane_in) {
    int tid = tid_in; asm volatile("" : "+v"(tid)); const int lane = tid & 63; (void)lane_in;
    unsigned char* ws = a.ws; const bf16* PROJ = (const bf16*)(ws + WS_R1); bf16* MG = (bf16*)(ws + WS_H);
    LAS bf16* Vt = (LAS bf16*)lds;
    LAS float* ssl = (LAS float*)(lds + (128 * GM_LDT + 64) * 2);
    const int R0 = chunk * 128;
    const int tq = wave & 3, chh = wave >> 2, hf = lane >> 5, l31 = lane & 31;
    const int t = 32 * tq + l31, row = R0 + t;
    bf16x8 bfr[8]; v2u uw[2][4];
    { const bf16* wsb = (const bf16*)(ws + WS_WSB) + ((size_t)(layer * 8 + g) * 128 + t) * 128 + 8 * hf;
#pragma unroll
      for (int ks = 0; ks < 8; ++ks) bfr[ks] = *(const bf16x8*)(wsb + 16 * ks);
      const bf16* up = PROJ + (size_t)row * PW + C_U + g * 128 + 64 * chh + 4 * hf;
#pragma unroll
      for (int cb = 0; cb < 2; ++cb)
#pragma unroll
          for (int g4 = 0; g4 < 4; ++g4) uw[cb][g4] = *(const v2u*)(up + 32 * cb + 8 * g4); }
    const float bias = a.in[6][(size_t)layer * 1024 + g * 128 + t];
    {
        const int s = tid >> 2, q = tid & 3;
        const v4u* vp = (const v4u*)(PROJ + (size_t)(R0 + s) * PW + C_VA + g * 128 + 32 * q);
        float x[32];
#pragma unroll
        for (int i = 0; i < 4; ++i) { const v4u w = vp[i]; x[8 * i + 0] = bflo(w.x); x[8 * i + 1] = bfhi(w.x); x[8 * i + 2] = bflo(w.y); x[8 * i + 3] = bfhi(w.y);
            x[8 * i + 4] = bflo(w.z); x[8 * i + 5] = bfhi(w.z); x[8 * i + 6] = bflo(w.w); x[8 * i + 7] = bfhi(w.w); }
        float sm = 0.f;
#pragma unroll
        for (int i = 0; i < 32; ++i) sm += x[i];
        sm += __shfl_xor(sm, 1); sm += __shfl_xor(sm, 2);
        const float mu = sm * (1.0f / 128.0f); float vq = 0.f;
#pragma unroll
        for (int i = 0; i < 32; ++i) { x[i] -= mu; vq += x[i] * x[i]; }
        vq += __shfl_xor(vq, 1); vq += __shfl_xor(vq, 2);
        const float rs = 1.0f / sqrtf(vq * (1.0f / 128.0f) + EPS);
        const f32x4* gn4 = (const f32x4*)(a.in[4] + (size_t)layer * 1024 + g * 128 + 32 * q);
        float gn[32];
#pragma unroll
        for (int i = 0; i < 8; ++i) { const f32x4 gv = gn4[i]; gn[4 * i] = gv[0]; gn[4 * i + 1] = gv[1]; gn[4 * i + 2] = gv[2]; gn[4 * i + 3] = gv[3]; }
#pragma unroll
        for (int i = 0; i < 32; i += 2) { const unsigned w = cvtpk(x[i] * rs * gn[i], x[i + 1] * rs * gn[i + 1]);
            Vt[(32 * q + i) * GM_LDT + 16 * q + s] = (bf16)(w & 0xffffu); Vt[(32 * q + i + 1) * GM_LDT + 16 * q + s] = (bf16)(w >> 16); }
    }
    __syncthreads();
    {
        f32x16 acc0, acc1;
#pragma unroll
        for (int i = 0; i < 16; ++i) { acc0[i] = 0.f; acc1[i] = 0.f; }
#pragma unroll
        for (int ks = 0; ks < 8; ++ks) {
            const bf16x8 a0 = *(const LAS bf16x8*)(Vt + (64 * chh + l31) * GM_LDT + 16 * (2 * chh) + 16 * ks + 8 * hf);
            const bf16x8 a1 = *(const LAS bf16x8*)(Vt + (64 * chh + 32 + l31) * GM_LDT + 16 * (2 * chh + 1) + 16 * ks + 8 * hf);
            acc0 = __builtin_amdgcn_mfma_f32_32x32x16_bf16(a0, bfr[ks], acc0, 0, 0, 0);
            acc1 = __builtin_amdgcn_mfma_f32_32x32x16_bf16(a1, bfr[ks], acc1, 0, 0, 0);
        }
        bf16* op = MG + (size_t)row * D + g * 128 + 64 * chh + 4 * hf;
        float ss = 0.f;
#pragma unroll
        for (int cb = 0; cb < 2; ++cb)
#pragma unroll
            for (int g4 = 0; g4 < 4; ++g4) {
                const v2u uwv = uw[cb][g4];
                float o0, o1, o2, o3;
                if (cb == 0) { o0 = bflo(uwv.x) * (acc0[4 * g4 + 0] + bias); o1 = bfhi(uwv.x) * (acc0[4 * g4 + 1] + bias); o2 = bflo(uwv.y) * (acc0[4 * g4 + 2] + bias); o3 = bfhi(uwv.y) * (acc0[4 * g4 + 3] + bias); }
                else         { o0 = bflo(uwv.x) * (acc1[4 * g4 + 0] + bias); o1 = bfhi(uwv.x) * (acc1[4 * g4 + 1] + bias); o2 = bflo(uwv.y) * (acc1[4 * g4 + 2] + bias); o3 = bfhi(uwv.y) * (acc1[4 * g4 + 3] + bias); }
                ss += (o0 * o0 + o1 * o1) + (o2 * o2 + o3 * o3);
                v2u ow; ow.x = cvtpk(o0, o1); ow.y = cvtpk(o2, o3);
                *(v2u*)(op + 32 * cb + 8 * g4) = ow;
            }
        ss += __shfl_xor(ss, 32);
        if (hf == 0) ssl[chh * 128 + t] = ss;
    }
    __syncthreads();
    if (tid < 128) ((float*)(ws + WS_SSA))[(size_t)g * T + R0 + tid] = ssl[tid] + ssl[128 + tid];
}

__device__ __forceinline__ unsigned voff_b(unsigned row, unsigned ch) { return 256u * row + 16u * (ch ^ (((row & 3) << 2) | ((row >> 2) & 3))); }
typedef short v4i16_t __attribute__((ext_vector_type(4)));
__device__ __forceinline__ s16x4 vtr(const LAS unsigned char* p) { return __builtin_bit_cast(s16x4, __builtin_amdgcn_ds_read_tr16_b64_v4i16((LAS v4i16_t*)p)); }

__device__ __forceinline__ void glds16(const void* gsrc, unsigned lds_dst) { unsigned keep;
    asm volatile("s_mov_b32 %0, m0\n\ts_mov_b32 m0, %2\n\ts_nop 0\n\tglobal_load_lds_dwordx4 %1, off\n\ts_mov_b32 m0, %0" : "=&s"(keep) : "v"(gsrc), "s"(lds_dst) : "memory"); }
__device__ __forceinline__ void glds16s(const void* sbase, unsigned voff, unsigned lds_dst) { unsigned keep;
    asm volatile("s_mov_b32 %0, m0\n\ts_mov_b32 m0, %3\n\ts_nop 0\n\tglobal_load_lds_dwordx4 %1, %2\n\ts_mov_b32 m0, %0" : "=&s"(keep) : "v"(voff), "s"(sbase), "s"(lds_dst) : "memory"); }
#define ATT_DMA_FAST(FIRST, COLBASE, BUF) do { \
        const bf16* sb_ = PROJ + (size_t)(seq_base + r + dd * (FIRST)) * PW + (COLBASE) + h * 128; \
        const unsigned l0_ = (unsigned)__builtin_amdgcn_readfirstlane((int)(unsigned)(uintptr_t)(BUF)); \
        _Pragma("unroll") for (int i_ = 0; i_ < 8; ++i_) glds16s(sb_ + (size_t)i_ * 4 * dd * PW, voffs[i_ & 3], l0_ + 1024u * i_); \
    } while (0)
#define ATT_DMA_ANY(FIRST, COLBASE, BUF) do { if (edge) ATT_DMA(FIRST, COLBASE, BUF); else ATT_DMA_FAST(FIRST, COLBASE, BUF); } while (0)
#define ATT_DMA(FIRST, COLBASE, BUF) do { \
        int f0_ = (FIRST); asm volatile("" : "+s"(f0_)); \
        _Pragma("unroll") for (int i_ = 0; i_ < 8; ++i_) { const int row_ = 4 * i_ + (lane >> 4); int kj_ = f0_ + row_; kj_ = kj_ < 0 ? 0 : (kj_ >= L ? L - 1 : kj_); \
            const int ch_ = (lane & 15) ^ (((row_ & 3) << 2) | ((row_ >> 2) & 3)); \
            glds16(PROJ + (size_t)(seq_base + r + dd * kj_) * PW + (COLBASE) + h * 128 + 8 * ch_, (unsigned)__builtin_amdgcn_readfirstlane((int)(unsigned)(uintptr_t)((BUF) + 1024 * i_))); } \
    } while (0)
#define ATT_ROWFRAGS(DST, BUF) do { _Pragma("unroll") for (int s_ = 0; s_ < 8; ++s_) DST[s_] = *(const LAS bf16x8*)((BUF) + voff_b(l31, 2 * s_ + hf)); } while (0)
#define ATT_SOFTMAX_PV(KB, VBUF, WAITV) do { \
        if ((KB) == 0) { _Pragma("unroll") for (int i = 0; i < 16; ++i) { if ((i & 3) + 8 * (i >> 2) < lm) S[i] = -1e30f; } }            \
        else if ((KB) == 4) { _Pragma("unroll") for (int i = 0; i < 16; ++i) { if ((i & 3) + 8 * (i >> 2) > lm) S[i] = -1e30f; } }     \
        if (edge) { _Pragma("unroll") for (int i = 0; i < 16; ++i) { const int kj = J0 - 64 + 32 * (KB) + 4 * hf + (i & 3) + 8 * (i >> 2); if (kj < 0 || kj >= L) S[i] = -1e30f; } } \
        float bm = S[0]; \
        _Pragma("unroll") for (int i = 1; i < 16; ++i) bm = fmaxf(bm, S[i]); \
        bm = fmaxf(bm, __shfl_xor(bm, 32)); \
        const float mnew = fmaxf(mrun, bm); \
        const float alpha = __builtin_amdgcn_exp2f(mrun - mnew); \
        mrun = mnew; \
        float ps = 0.f; \
        _Pragma("unroll") for (int i = 0; i < 16; ++i) { S[i] = __builtin_amdgcn_exp2f(S[i] - mnew); ps += S[i]; } \
        lsum = lsum * alpha + ps; \
        _Pragma("unroll") for (int db = 0; db < 4; ++db) _Pragma("unroll") for (int i = 0; i < 16; ++i) O[db][i] *= alpha; \
        bf16x8 pf[2]; \
        _Pragma("unroll") for (int j = 0; j < 2; ++j) { v4u w; w.x = cvtpk(S[8 * j + 0], S[8 * j + 1]); w.y = cvtpk(S[8 * j + 2], S[8 * j + 3]); w.z = cvtpk(S[8 * j + 4], S[8 * j + 5]); w.w = cvtpk(S[8 * j + 6], S[8 * j + 7]); \
            pf[j] = __builtin_bit_cast(bf16x8, w); } \
        WAITV; \
        _Pragma("unroll") for (int db = 0; db < 4; ++db) _Pragma("unroll") for (int j = 0; j < 2; ++j) { \
                const s16x4 lo = vtr((VBUF) + tb[0][db] + 4096 * j); \
                const s16x4 hi = vtr((VBUF) + tb[1][db] + 4096 * j); \
                bf16x8 vf; vf[0] = lo[0]; vf[1] = lo[1]; vf[2] = lo[2]; vf[3] = lo[3]; vf[4] = hi[0]; vf[5] = hi[1]; vf[6] = hi[2]; vf[7] = hi[3]; \
                O[db] = __builtin_amdgcn_mfma_f32_32x32x16_bf16(vf, pf[j], O[db], 0, 0, 0); } \
    } while (0)
__device__ __forceinline__ void attn_wave_tile(const bf16* PROJ, int seq_base, int L, int dd, int r, int J0, int h, LAS unsigned char* vl, bf16* Oscr, float* lse_scr, int P0, int lane, int rot) {
    const int hf = lane >> 5, l31 = lane & 31;
    const bool edge = (J0 < 64) || (J0 + 96 > L);
    const int lm = l31 - 4 * hf;
    LAS unsigned char* kimg = vl; LAS unsigned char* vimg = vl + 8192;
    unsigned voffs[4];
    { const int q_ = lane >> 4;
#pragma unroll
      for (int k = 0; k < 4; ++k) voffs[k] = 2u * (unsigned)(q_ * dd * PW + 8 * ((lane & 15) ^ ((q_ << 2) | k))); }
    bf16x8 qf[8];
    ATT_DMA_FAST(J0, C_Q, kimg);
    asm volatile("s_waitcnt vmcnt(0)" ::: "memory");
    ATT_ROWFRAGS(qf, kimg);
    asm volatile("s_waitcnt lgkmcnt(0)" ::: "memory");
    const int kb0 = __builtin_amdgcn_readfirstlane((5 - rot) % 5);
    ATT_DMA_ANY(J0 - 64 + 32 * kb0, C_K, kimg); ATT_DMA_ANY(J0 - 64 + 32 * kb0, C_V, vimg);
    f32x16 O[4];
#pragma unroll
    for (int db = 0; db < 4; ++db)
#pragma unroll
        for (int i = 0; i < 16; ++i) O[db][i] = 0.f;
    float mrun = -1e30f, lsum = 0.f;
    unsigned tb[2][4];
    { const int blk = (lane >> 4) & 1, q4 = (lane & 15) >> 2, p4 = lane & 3;
#pragma unroll
      for (int t = 0; t < 2; ++t)
#pragma unroll
          for (int db = 0; db < 4; ++db) tb[t][db] = 256u * (4 * hf + q4 + 8 * t) + 64u * (db ^ q4) + 16u * ((2 * blk + (p4 >> 1)) ^ (hf + 2 * t)) + 8u * (p4 & 1); }
#pragma unroll 1
    for (int t = 0; t < 5; ++t) {
        const int kb = __builtin_amdgcn_readfirstlane((t + 5 - rot) % 5), kbn = __builtin_amdgcn_readfirstlane((t + 6 - rot) % 5);
        asm volatile("s_waitcnt vmcnt(8)" ::: "memory");
        f32x16 S;
#pragma unroll
        for (int i = 0; i < 16; ++i) S[i] = 0.f;
#pragma unroll
        for (int kk = 0; kk < 8; ++kk) { const bf16x8 kfr = *(const LAS bf16x8*)(kimg + voff_b(l31, 2 * kk + hf)); S = __builtin_amdgcn_mfma_f32_32x32x16_bf16(kfr, qf[kk], S, 0, 0, 0); }
        asm volatile("s_waitcnt lgkmcnt(0)" ::: "memory");
        if (t < 4) ATT_DMA_ANY(J0 - 64 + 32 * kbn, C_K, kimg);
        if (t < 4) { ATT_SOFTMAX_PV(kb, vimg, asm volatile("s_waitcnt vmcnt(8)" ::: "memory")); }
        else       { ATT_SOFTMAX_PV(kb, vimg, asm volatile("s_waitcnt vmcnt(0)" ::: "memory")); }
        asm volatile("s_waitcnt lgkmcnt(0)" ::: "memory");
        if (t < 4) ATT_DMA_ANY(J0 - 64 + 32 * kbn, C_V, vimg);
    }
    const float ltot = lsum + __shfl_xor(lsum, 32);
    const float inv = 1.0f / ltot;
    const int ql = r + dd * (J0 + l31) - P0;
    bf16* op = Oscr + (size_t)ql * 128 + 4 * hf;
#pragma unroll
    for (int db = 0; db < 4; ++db)
#pragma unroll
        for (int g4 = 0; g4 < 4; ++g4) { v2u w; w.x = cvtpk(O[db][4 * g4 + 0] * inv, O[db][4 * g4 + 1] * inv); w.y = cvtpk(O[db][4 * g4 + 2] * inv, O[db][4 * g4 + 3] * inv);
            *(v2u*)(op + 32 * db + 8 * g4) = w; }
    if (hf == 0) lse_scr[ql] = mrun + __builtin_amdgcn_logf(ltot);
}

__device__ __forceinline__ void attn_item(const Args& a, int h, int blk512, LAS unsigned char* lds, int tid_in, int wave, int lane_in) {
    int tid = tid_in; asm volatile("" : "+v"(tid)); int lane = tid & 63; (void)lane_in;
    unsigned char* ws = a.ws; const bf16* PROJ = (const bf16*)(ws + WS_R1); bf16* MG = (bf16*)(ws + WS_H);
    bf16* Oscr = (bf16*)(ws + WS_MIX) + (size_t)blockIdx.x * (3 * 512 * 128);
    float* lse = (float*)(ws + WS_LSE) + (size_t)blockIdx.x * (3 * 512);
    const int row0 = blk512 * 512;
    const int seq_base = row0 < T_P ? 0 : T_P, S = row0 < T_P ? T_P : T_S, P0 = row0 - seq_base;
    LAS unsigned char* vl = lds + wave * 16384;
#pragma unroll 1
    for (int p = 0; p < 3; ++p) {
        const int dd = p == 0 ? 1 : (p == 1 ? 4 : 16), tpr = 16 / dd, L = S / dd;
#pragma unroll 1
        for (int tt = 0; tt < 2; ++tt) {
            const int tau = wave + 8 * tt, r = tau / tpr, w = tau % tpr;
            attn_wave_tile(PROJ, seq_base, L, dd, r, P0 / dd + 32 * w, h, vl, Oscr + (size_t)p * 512 * 128, lse + p * 512, P0, lane, w % 5);
        }
    }
    __syncthreads();
    asm volatile("" : "+v"(lane));
    float* ssB = (float*)(ws + WS_SSB) + (size_t)h * T;
#pragma unroll 4
    for (int st = 0; st < 16; ++st) {
        const int pl = st * 32 + wave * 4 + (lane >> 4), ch = lane & 15;
        const float l0 = lse[pl], l1 = lse[512 + pl], l2 = lse[1024 + pl];
        const float mx = fmaxf(l0, fmaxf(l1, l2));
        float w0 = __builtin_amdgcn_exp2f(l0 - mx), w1 = __builtin_amdgcn_exp2f(l1 - mx), w2 = __builtin_amdgcn_exp2f(l2 - mx);
        const float iw = 1.0f / (w0 + w1 + w2); w0 *= iw; w1 *= iw; w2 *= iw;
        const v4u a0 = *(const v4u*)(Oscr + (size_t)pl * 128 + 8 * ch), a1 = *(const v4u*)(Oscr + (size_t)(512 + pl) * 128 + 8 * ch), a2 = *(const v4u*)(Oscr + (size_t)(1024 + pl) * 128 + 8 * ch);
        float o[8];
        o[0] = w0 * bflo(a0.x) + w1 * bflo(a1.x) + w2 * bflo(a2.x); o[1] = w0 * bfhi(a0.x) + w1 * bfhi(a1.x) + w2 * bfhi(a2.x);
        o[2] = w0 * bflo(a0.y) + w1 * bflo(a1.y) + w2 * bflo(a2.y); o[3] = w0 * bfhi(a0.y) + w1 * bfhi(a1.y) + w2 * bfhi(a2.y);
        o[4] = w0 * bflo(a0.z) + w1 * bflo(a1.z) + w2 * bflo(a2.z); o[5] = w0 * bfhi(a0.z) + w1 * bfhi(a1.z) + w2 * bfhi(a2.z);
        o[6] = w0 * bflo(a0.w) + w1 * bflo(a1.w) + w2 * bflo(a2.w); o[7] = w0 * bfhi(a0.w) + w1 * bfhi(a1.w) + w2 * bfhi(a2.w);
        float ss = 0.f;
#pragma unroll
        for (int i = 0; i < 8; ++i) ss += o[i] * o[i];
        ss += __shfl_xor(ss, 1); ss += __shfl_xor(ss, 2); ss += __shfl_xor(ss, 4); ss += __shfl_xor(ss, 8);
        v4u ow; ow.x = cvtpk(o[0], o[1]); ow.y = cvtpk(o[2], o[3]); ow.z = cvtpk(o[4], o[5]); ow.w = cvtpk(o[6], o[7]);
        *(v4u*)(MG + (size_t)(row0 + pl) * D + 1024 + h * 128 + 8 * ch) = ow;
        if (ch == 0) ssB[row0 + pl] = ss;
    }
    __syncthreads();
}

#define XB_TMO      128
#define XB_XCNT(j)  (256  + 64 * (j))
#define XB_XSUB(j)  (1280 + 64 * (j))
#define XB_XGEN(j)  (2304 + 64 * (j))
#define XB_TOP      3328
#define XB_TOPGEN   3392
#define XCD_BAR_WORDS 3456
#define XB_SPIN_CAP (1u << 18)

__device__ __forceinline__ unsigned xb_ld(unsigned* p)              { return __hip_atomic_load(p, __ATOMIC_RELAXED, __HIP_MEMORY_SCOPE_AGENT); }
__device__ __forceinline__ unsigned xb_add(unsigned* p, unsigned v) { return __hip_atomic_fetch_add(p, v, __ATOMIC_RELAXED, __HIP_MEMORY_SCOPE_AGENT); }
__device__ __forceinline__ unsigned xb_xcc_id() { return (unsigned)__builtin_amdgcn_s_getreg((3 << 11) | 20) & 0xFu; }
#define XB_SPIN(cond, bar) do { unsigned _sp = 0; while (cond) { __builtin_amdgcn_s_sleep(1); \
    if ((++_sp & 255u) == 0u) { if (xb_ld(&(bar)[XB_TMO])) break; if (_sp > XB_SPIN_CAP) { atomicAdd(&(bar)[XB_TMO], 1u); break; } } } } while (0)

struct XcdBarrier {
    unsigned* bar; unsigned x;
    volatile LAS unsigned* st;
};

__device__ __forceinline__ XcdBarrier xcd_barrier_post(unsigned* bar, volatile LAS unsigned* st, int wave_s) {
    XcdBarrier b; b.bar = bar; b.x = xb_xcc_id(); b.st = st;
    if (wave_s == 0 && fresh_lane() == 0) (void)xb_add(&bar[XB_XCNT(b.x)], 1u);
    return b;
}
__device__ __forceinline__ void xcd_barrier_complete(unsigned* bar, unsigned x, unsigned& nloc, unsigned& nx) {
    const unsigned G = gridDim.x * gridDim.y * gridDim.z;
    unsigned sum, cnt, mine, sp = 0u;
    for (;;) {
        sum = 0u; cnt = 0u; mine = 0u;
#pragma unroll
        for (unsigned j = 0; j < 16; ++j) { const unsigned c = xb_ld(&bar[XB_XCNT(j)]); sum += c; cnt += (c > 0u) ? 1u : 0u; mine = (j == x) ? c : mine; }
        if (sum == G) break;
        __builtin_amdgcn_s_sleep(1);
        if ((++sp & 255u) == 0u) { if (xb_ld(&bar[XB_TMO])) break; if (sp > XB_SPIN_CAP) { atomicAdd(&bar[XB_TMO], 1u); break; } }
    }
    nloc = mine > 0u ? mine : 1u; nx = cnt > 0u ? cnt : 1u;
}

__device__ __forceinline__ void xcd_barrier(const XcdBarrier& b, int wave_s) {
    asm volatile("s_waitcnt vmcnt(0)" ::: "memory");
    __syncthreads();
    if (wave_s == 0 && fresh_lane() == 0) {
        unsigned* bar = b.bar;
        __builtin_amdgcn_s_waitcnt(0);
        unsigned nloc = b.st[0], nx = b.st[1];
        if (nloc == 0u) { xcd_barrier_complete(bar, b.x, nloc, nx); b.st[0] = nloc; b.st[1] = nx; }
        const unsigned old = xb_add(&bar[XB_XSUB(b.x)], 1u);
        const unsigned gen = old / nloc;
        if (old + 1u == (gen + 1u) * nloc) {
            __builtin_amdgcn_fence(__ATOMIC_RELEASE, "agent");
            asm volatile("s_waitcnt vmcnt(0)" ::: "memory");
            const unsigned og = xb_add(&bar[XB_TOP], 1u);
            const unsigned tg = og / nx;
            if (og + 1u == (tg + 1u) * nx) xb_add(&bar[XB_TOPGEN], 1u);
            else XB_SPIN(xb_ld(&bar[XB_TOPGEN]) == tg, bar);
            __builtin_amdgcn_fence(__ATOMIC_ACQUIRE, "agent");
            xb_add(&bar[XB_XGEN(b.x)], 1u);
            asm volatile("s_waitcnt vmcnt(0)" ::: "memory");
        } else {
            XB_SPIN(xb_ld(&bar[XB_XGEN(b.x)]) == gen, bar);
            __builtin_amdgcn_fence(__ATOMIC_ACQUIRE, "agent");
            asm volatile("s_waitcnt vmcnt(0)" ::: "memory");
        }
    }
    __syncthreads();
}

__global__ void __launch_bounds__(NTHREADS, 2) fwd_megakernel(Args a) {
    extern __shared__ __attribute__((aligned(16))) unsigned char lds_raw[];
    LAS unsigned char* lds = (LAS unsigned char*)lds_raw;
    cg::grid_group grid = cg::this_grid();
#define PHASE_IDS() int tid = fresh_tid(wave_s); asm volatile("" : "+v"(tid)); const int lane = tid & 63, wave = __builtin_amdgcn_readfirstlane(tid >> 6); \
    int bid = blockIdx.x; asm volatile("" : "+s"(bid)); const int gw = bid * NWAVES + wave, NGW = G * NWAVES; (void)lane; (void)gw; (void)NGW;
    const int G = gridDim.x;
    const int wave_s = __builtin_amdgcn_readfirstlane(threadIdx.x >> 6);
    unsigned char* ws = a.ws;
    const float* rope = (const float*)(ws + WS_ROPE);
    {
        volatile LAS unsigned* misc0 = (volatile LAS unsigned*)(lds + MISC_OFF);
        if (threadIdx.x < 16) misc0[threadIdx.x] = 0u;
        if (blockIdx.x == 0) for (int i = threadIdx.x; i < 4096; i += NTHREADS) ((unsigned*)(ws + WS_CTL))[i] = 0u;
        __syncthreads();
    }

    for (int rep = 0; rep < REP_PRO; ++rep) { PHASE_IDS(); prologue_phase(a, lds, gw, NGW, wave, lane); }
    { PHASE_IDS(); resnorm_phase<true, false>(a, nullptr, a.in[2], gw, NGW, lane); }
    grid.sync();
    const XcdBarrier bar = xcd_barrier_post((unsigned*)(ws + WS_CTL), (volatile LAS unsigned*)(lds + MISC_OFF), wave_s);

#pragma unroll 1
    for (int l = 0; l < DEPTH; ++l) {
        {
            pg8::Gemm g{(const bf16*)(ws + WS_H), (const bf16*)(ws + WS_WIN) + (size_t)l * PW * D, T, PW, D};
            pg8::StaticOrder S; S.init(T, PW, G, (int)blockIdx.x);
            pg8::EpiProj E{(bf16*)(ws + WS_R1), rope, QSCALE};

            for (int rep = 0; rep < REP_GEMM; ++rep) { pg8::gemm_phase<pg8::EpiProj, pg8::StaticOrder, true, true>(lds, g, S, E, wave_s); }
        }
        xcd_barrier(bar, wave_s);
        {
            constexpr int N_ATT = 8 * (T / 512), N_GM = 8 * (T / 128);
            PHASE_IDS(); (void)bid;
            unsigned* qhead = (unsigned*)(ws + WS_CTL) + 3584 + 64 * l;
            volatile LAS int* slot = (volatile LAS int*)(lds + MISC_OFF + 64);
            if (tid == 0) *slot = (int)__hip_atomic_fetch_add(qhead, 1u, __ATOMIC_RELAXED, __HIP_MEMORY_SCOPE_AGENT);
            __syncthreads();
            int it = *slot;
            while (it < N_ATT + N_GM) {
                __syncthreads();
                if (tid == 0) *slot = (int)__hip_atomic_fetch_add(qhead, 1u, __ATOMIC_RELAXED, __HIP_MEMORY_SCOPE_AGENT);
                if (it < N_ATT) attn_item(a, it & 7, it >> 3, lds, tid, wave, lane);
                else { const int j = it - N_ATT; gmlp_item(a, l, j >> 3, j & 7, lds, tid, wave, lane); }
                __syncthreads();
                it = *slot;
            }
        }
        xcd_barrier(bar, wave_s);
        {
            pg8::Gemm g{(const bf16*)(ws + WS_H), (const bf16*)(ws + WS_WO) + (size_t)l * D * D, T, D, D};
            pg8::StaticOrder S; S.init(T, D, G, (int)blockIdx.x);
            pg8::EpiMixKS E{(bf16*)(ws + WS_MIX), (float*)(ws + WS_SSM), (const float*)(ws + WS_SSA), (const float*)(ws + WS_SSB), (LAS float*)(lds + 131072), T};
            for (int rep = 0; rep < REP_GEMM; ++rep) { pg8::gemm_phase<pg8::EpiMixKS, pg8::StaticOrder, true, true>(lds, g, S, E, wave_s); }
        }
        xcd_barrier(bar, wave_s);
        { PHASE_IDS(); resnorm_phase<false, false>(a, a.in[10] + (size_t)l * D, a.in[11] + (size_t)l * D, gw, NGW, lane); }
        xcd_barrier(bar, wave_s);
        {
            pg8::Gemm g{(const bf16*)(ws + WS_H), (const bf16*)(ws + WS_WGU) + (size_t)l * 2 * FF * D, T, 2 * FF, D};
            pg8::StaticOrder S; S.init(T, 2 * FF, G, (int)blockIdx.x);
            pg8::EpiGU E{(bf16*)(ws + WS_R1)};

            for (int rep = 0; rep < REP_GEMM; ++rep) { pg8::gemm_phase<pg8::EpiGU, pg8::StaticOrder, true, true>(lds, g, S, E, wave_s); }
        }
        xcd_barrier(bar, wave_s);
        {
            pg8::Gemm g{(const bf16*)(ws + WS_R1), (const bf16*)(ws + WS_WDN) + (size_t)l * D * FF, T, D, FF};
            pg8::StaticOrder S; S.init(T, D, G, (int)blockIdx.x);
            pg8::EpiMix E{(bf16*)(ws + WS_MIX), (float*)(ws + WS_SSM)};

            for (int rep = 0; rep < REP_GEMM; ++rep) { pg8::gemm_phase<pg8::EpiMix, pg8::StaticOrder, true, true>(lds, g, S, E, wave_s); }
        }
        xcd_barrier(bar, wave_s);
        if (l + 1 < DEPTH) { { PHASE_IDS(); resnorm_phase<false, false>(a, a.in[15] + (size_t)l * D, a.in[2] + (size_t)(l + 1) * D, gw, NGW, lane); } xcd_barrier(bar, wave_s); }
        else { PHASE_IDS(); resnorm_phase<false, true>(a, a.in[15] + (size_t)l * D, nullptr, gw, NGW, lane); }
    }
}

extern "C" void kernel_launch(void* const* d_in, const int* in_sizes, int n_in, void* d_out, int out_size, void* d_ws, size_t ws_size, hipStream_t stream) {
    static int grid = 0;
    if (grid == 0) {
        if (n_in != 16 || out_size != T * D || ws_size < WS_END) { fprintf(stderr, "kernel_launch: unexpected shapes (n_in %d, out %d, ws %zu); nothing launched\n", n_in, out_size, ws_size); grid = -1; return; }
        int dev = 0, cus = 0, per_cu = 0;
        hipGetDevice(&dev); hipDeviceGetAttribute(&cus, hipDeviceAttributeMultiprocessorCount, dev);
        if (hipFuncSetAttribute((const void*)fwd_megakernel, hipFuncAttributeMaxDynamicSharedMemorySize, LDS_BYTES) != hipSuccess) { fprintf(stderr, "kernel_launch: hipFuncSetAttribute failed\n"); grid = -1; return; }
        if (hipOccupancyMaxActiveBlocksPerMultiprocessor(&per_cu, (const void*)fwd_megakernel, NTHREADS, LDS_BYTES) != hipSuccess || per_cu < 1) { fprintf(stderr, "kernel_launch: occupancy query says %d\n", per_cu); per_cu = 1; }
        (void)hipGetLastError();
        grid = cus * (per_cu > 1 ? 1 : per_cu);
        if (grid <= 0) grid = 256;
    }
    if (grid < 0) return;
    Args a{};
    for (int i = 0; i < 16; ++i) a.in[i] = (const float*)d_in[i];
    a.out = (float*)d_out; a.ws = (unsigned char*)d_ws;
    void* args[] = {&a};
    hipError_t e = hipLaunchCooperativeKernel((const void*)fwd_megakernel, dim3(grid), dim3(NTHREADS), args, LDS_BYTES, stream);
    if (e != hipSuccess) fprintf(stderr, "kernel_launch: cooperative launch failed: %s (grid %d)\n", hipGetErrorString(e), grid);
}
```

```cpp
#include <hip/hip_runtime.h>
#include <hip/hip_cooperative_groups.h>
#include <cstdio>
#include <cstdint>
namespace cg = cooperative_groups;
#ifndef REP_GEMM
#define REP_GEMM 1
#endif
#ifndef REP_MIX
#define REP_MIX 1
#endif
#ifndef REP_ATT
#define REP_ATT 1
#endif
#ifndef REP_PRO
#define REP_PRO 1
#endif
__device__ __forceinline__ int fresh_lane() { int l; asm volatile("v_mbcnt_lo_u32_b32 %0, -1, 0\n\tv_mbcnt_hi_u32_b32 %0, -1, %0" : "=v"(l)); return l; }
__device__ __forceinline__ int fresh_tid(int wave_s) { return wave_s * 64 + fresh_lane(); }
namespace pg8 {
#define PG8_LAS __attribute__((address_space(3)))
typedef unsigned short bf16_t;
typedef short bf16x8 __attribute__((ext_vector_type(8)));
typedef float f32x4 __attribute__((ext_vector_type(4)));
typedef unsigned u32x4 __attribute__((ext_vector_type(4)));
constexpr int BM = 256, BK = 64, HALF = 128, HTB = HALF * BK * 2  , STAGE_BYTES = 8 * HTB, NXCD = 8, WGM = 8;

__host__ __device__ __forceinline__ int lds_byte(int r, int c) { const int st = (r >> 4) * 2 + (c >> 5), rr = r & 15, cc = c & 31, ob = rr * 64 + cc * 2; return st * 1024 + (ob ^ (((ob >> 9) & 1) << 5)); }
__host__ __device__ __forceinline__ void stage_rc(int b, int& R, int& C) { const int st = b / 1024, sb = b % 1024, swz = sb ^ (((sb >> 9) & 1) << 5); R = (st >> 1) * 16 + swz / 64; C = (st & 1) * 32 + (swz % 64) / 2; }
__host__ __device__ __forceinline__ int perm32(int rho) { const int n = rho >> 4, i = rho & 15; return 8 * (i >> 2) + 4 * n + (i & 3); }

struct Unit { int pm, pn; };
struct Gemm { const bf16_t* A; const bf16_t* Bt; int M, N, K; };

struct StaticOrder {
    int nM, nN, nwg, G, c;
    __host__ __device__ void init(int M, int N, int G_, int c_) { nM = M / BM; nN = N / BM; nwg = nM * nN; G = G_; c = c_; }
    __host__ __device__ bool next(int i, Unit& u) const {
        const long L = (long)i * G + c; if (L >= nwg) return false;
        int wgid = (int)L; { const int q = nwg / NXCD, r = nwg % NXCD, xcd = wgid % NXCD, off = wgid / NXCD; wgid = (xcd < r ? xcd * (q + 1) : r * (q + 1) + (xcd - r) * q) + off; }
        const int nig = WGM * nN, gid = wgid / nig, fm = gid * WGM, gsz = (nM - fm) < WGM ? (nM - fm) : WGM;
        u.pm = fm + ((wgid % nig) % gsz); u.pn = (wgid % nig) / gsz; return true;
    }
    __device__ __forceinline__ void a_ready(const Unit&) const {}
    __device__ __forceinline__ void done(const Unit&) const {}
};
__device__ __forceinline__ unsigned cvt_pk_bf16(float lo, float hi) { unsigned r; asm volatile("v_cvt_pk_bf16_f32 %0, %1, %2" : "=v"(r) : "v"(lo), "v"(hi)); return r; }
typedef float f32x2 __attribute__((ext_vector_type(2)));
__device__ __forceinline__ float fast_sigmoid(float t) { return __builtin_amdgcn_rcpf(1.0f + __builtin_amdgcn_exp2f(-1.44269504089f * t)); }
__device__ __forceinline__ float gelu_tanh(float x) { const float t = 1.5957691216057308f * (x + 0.044715f * x * x * x); return x * fast_sigmoid(t); }
__device__ __forceinline__ float silu_f(float x) { return x * fast_sigmoid(x); }
typedef unsigned u32x2 __attribute__((ext_vector_type(2)));

struct EpiProj {
    static constexpr bool PERM = false, AFTER_DRAIN = false, KSPLIT = false;
    bf16_t* O; const float* rope; float qscale;
    __device__ __forceinline__ void operator()(const f32x4 (&acc)[2][2][4][2], const Unit& u, int wr, int wc, int fr, int fq) const {
        const int row0 = u.pm * BM + wr * 64 + fr, col0 = u.pn * BM + wc * 32 + 4 * fq;
        const int kind = u.pn >> 2;
        const bool do_rope = (kind == 2 || kind == 3) && (wc == 0);
#pragma unroll
        for (int ai = 0; ai < 2; ++ai)
#pragma unroll
            for (int m = 0; m < 4; ++m) {
                const int row = row0 + ai * HALF + m * 16;
                const int pos = row < 8192 ? row : row - 8192;
                bf16_t* rowp = O + (size_t)row * 5120 + col0;
                f32x4 cs = (f32x4){1.f, 1.f, 1.f, 1.f}, sn = (f32x4){0.f, 0.f, 0.f, 0.f};
                if (do_rope) { cs = *(const f32x4*)(rope + pos * 32 + 4 * fq); sn = *(const f32x4*)(rope + pos * 32 + 16 + 4 * fq); }
#pragma unroll
                for (int bj = 0; bj < 2; ++bj) {
                    f32x4 v0 = acc[ai][bj][m][0], v1 = acc[ai][bj][m][1];
                    if (kind < 2) {
#pragma unroll
                        for (int j = 0; j < 4; ++j) { v0[j] = gelu_tanh(v0[j]); v1[j] = gelu_tanh(v1[j]); }
                    } else if (do_rope) {
                        const f32x4 o0 = v0 * cs - v1 * sn, o1 = v1 * cs + v0 * sn; v0 = o0; v1 = o1;
                    }
                    if (kind == 2) { v0 = v0 * qscale; v1 = v1 * qscale; }
                    u32x2 w0, w1; w0.x = cvt_pk_bf16(v0[0], v0[1]); w0.y = cvt_pk_bf16(v0[2], v0[3]); w1.x = cvt_pk_bf16(v1[0], v1[1]); w1.y = cvt_pk_bf16(v1[2], v1[3]);
                    *(u32x2*)(rowp + bj * HALF) = w0; *(u32x2*)(rowp + bj * HALF + 16) = w1;
                }
            }
    }
};
struct EpiGU {
    static constexpr bool PERM = true, AFTER_DRAIN = false, KSPLIT = false;
    bf16_t* O;
    __device__ __forceinline__ void operator()(const f32x4 (&acc)[2][2][4][2], const Unit& u, int wr, int wc, int fr, int fq) const {
        const int row0 = u.pm * BM + wr * 64 + fr, col0 = u.pn * HALF + wc * 32 + 8 * fq;
#pragma unroll
        for (int ai = 0; ai < 2; ++ai)
#pragma unroll
            for (int m = 0; m < 4; ++m) {
                bf16_t* rowp = O + (size_t)(row0 + ai * HALF + m * 16) * 5632 + col0;
                f32x4 r0, r1;
#pragma unroll
                for (int j = 0; j < 4; ++j) { r0[j] = silu_f(acc[ai][0][m][0][j]) * acc[ai][1][m][0][j]; r1[j] = silu_f(acc[ai][0][m][1][j]) * acc[ai][1][m][1][j]; }
                u32x4 w; w.x = cvt_pk_bf16(r0[0], r0[1]); w.y = cvt_pk_bf16(r0[2], r0[3]); w.z = cvt_pk_bf16(r1[0], r1[1]); w.w = cvt_pk_bf16(r1[2], r1[3]);
                *(u32x4*)rowp = w;
            }
    }
};
struct EpiMix {
    static constexpr bool PERM = true, AFTER_DRAIN = false, KSPLIT = false;
    bf16_t* O; float* ss;
    __device__ __forceinline__ void operator()(const f32x4 (&acc)[2][2][4][2], const Unit& u, int wr, int wc, int fr, int fq) const {
        const int row0 = u.pm * BM + wr * 64 + fr, col0 = u.pn * BM + wc * 32 + 8 * fq;
#pragma unroll
        for (int ai = 0; ai < 2; ++ai)
#pragma unroll
            for (int m = 0; m < 4; ++m) {
                const int row = row0 + ai * HALF + m * 16;
                bf16_t* rowp = O + (size_t)row * 2048 + col0;
                float s = 0.f;
#pragma unroll
                for (int bj = 0; bj < 2; ++bj) {
                    const f32x4 v0 = acc[ai][bj][m][0], v1 = acc[ai][bj][m][1];
                    s += (v0[0] * v0[0] + v0[1] * v0[1]) + (v0[2] * v0[2] + v0[3] * v0[3]) + (v1[0] * v1[0] + v1[1] * v1[1]) + (v1[2] * v1[2] + v1[3] * v1[3]);
                    u32x4 w; w.x = cvt_pk_bf16(v0[0], v0[1]); w.y = cvt_pk_bf16(v0[2], v0[3]); w.z = cvt_pk_bf16(v1[0], v1[1]); w.w = cvt_pk_bf16(v1[2], v1[3]);
                    *(u32x4*)(rowp + bj * HALF) = w;
                }
                s += __shfl_xor(s, 16); s += __shfl_xor(s, 32);
                if (fq == 0) ss[(size_t)row * 32 + u.pn * 4 + wc] = s;
            }
    }
};

struct EpiMixKS {
    static constexpr bool PERM = true, AFTER_DRAIN = false, KSPLIT = true;
    bf16_t* O; float* ss; const float* ssA; const float* ssB; PG8_LAS float* tbl; int Trows;
    __device__ __forceinline__ void prep(const Unit& u, int ui, int tid) const {
        if (tid < 256) {
            const int row = u.pm * BM + tid; float sa = 0.f, sb = 0.f;
#pragma unroll
            for (int g = 0; g < 8; ++g) { sa += ssA[(size_t)g * Trows + row]; sb += ssB[(size_t)g * Trows + row]; }
            const float rA = 1.0f / sqrtf(sa * (1.0f / 1024.0f) + 1e-6f), rB = 1.0f / sqrtf(sb * (1.0f / 1024.0f) + 1e-6f);
            tbl[(ui & 1) * 512 + tid * 2 + 0] = rA / rB; tbl[(ui & 1) * 512 + tid * 2 + 1] = rB;
        }
    }
    __device__ __forceinline__ void mid(f32x4 (&acc)[2][2][4][2], int ui, int wr, int fr) const {
#pragma unroll
        for (int ai = 0; ai < 2; ++ai)
#pragma unroll
            for (int m = 0; m < 4; ++m) { const float sc = tbl[(ui & 1) * 512 + (ai * HALF + wr * 64 + m * 16 + fr) * 2];
#pragma unroll
                for (int bj = 0; bj < 2; ++bj)
#pragma unroll
                    for (int n = 0; n < 2; ++n) acc[ai][bj][m][n] = acc[ai][bj][m][n] * sc; }
    }
    __device__ __forceinline__ void epi_ks(const f32x4 (&acc)[2][2][4][2], const Unit& u, int ui, int wr, int wc, int fr, int fq) const {
        const int row0 = u.pm * BM + wr * 64 + fr, col0 = u.pn * BM + wc * 32 + 8 * fq;
#pragma unroll
        for (int ai = 0; ai < 2; ++ai)
#pragma unroll
            for (int m = 0; m < 4; ++m) {
                const int row = row0 + ai * HALF + m * 16;
                const float sc = tbl[(ui & 1) * 512 + (ai * HALF + wr * 64 + m * 16 + fr) * 2 + 1];
                bf16_t* rowp = O + (size_t)row * 2048 + col0;
                float s = 0.f;
#pragma unroll
                for (int bj = 0; bj < 2; ++bj) {
                    const f32x4 v0 = acc[ai][bj][m][0] * sc, v1 = acc[ai][bj][m][1] * sc;
                    s += (v0[0] * v0[0] + v0[1] * v0[1]) + (v0[2] * v0[2] + v0[3] * v0[3]) + (v1[0] * v1[0] + v1[1] * v1[1]) + (v1[2] * v1[2] + v1[3] * v1[3]);
                    u32x4 w; w.x = cvt_pk_bf16(v0[0], v0[1]); w.y = cvt_pk_bf16(v0[2], v0[3]); w.z = cvt_pk_bf16(v1[0], v1[1]); w.w = cvt_pk_bf16(v1[2], v1[3]);
                    *(u32x4*)(rowp + bj * HALF) = w;
                }
                s += __shfl_xor(s, 16); s += __shfl_xor(s, 32);
                if (fq == 0) ss[(size_t)row * 32 + u.pn * 4 + wc] = s;
            }
    }
    __device__ __forceinline__ void operator()(const f32x4 (&)[2][2][4][2], const Unit&, int, int, int, int) const {}
};

template <class Epi, class Sched, bool ALIGN_EPI = false, bool SP2 = false>
__device__ __forceinline__ void gemm_phase(PG8_LAS unsigned char* lds, const Gemm g, const Sched& S, const Epi& E, int wave_s) {
    int tid_ = fresh_tid(wave_s); asm volatile("" : "+v"(tid_));
    const int tid = tid_, wid = __builtin_amdgcn_readfirstlane(tid >> 6), lane = tid & 63, wr = wid >> 2, wc = wid & 3, fr = lane & 15, fq = lane >> 4;
    const int K = g.K, nt = K / BK;
    unsigned voffA[2], voffB[2];
#pragma unroll
    for (int i = 0; i < 2; ++i) { int R, C; stage_rc(tid * 16 + i * 8192, R, C); const int Rb = Epi::PERM ? ((R & ~31) + perm32(R & 31)) : R;
        voffA[i] = (unsigned)(R * K + C) * 2u; voffB[i] = (unsigned)(Rb * K + C) * 2u; }
    const size_t kstep = (size_t)(BK * 2);
    const size_t hstep = (size_t)HALF * K * 2;
    const size_t tstep = 2 * hstep;
    const unsigned ldsw = (unsigned)wid * 1024u;
    const int aoff = lds_byte(wr * 64 + fr, fq * 8), boff = lds_byte(wc * 32 + fr, fq * 8);
#define PG8_SA(b, h) (((b) * 2 + (h)) * HTB)
#define PG8_SB(b, h) ((4 + (b) * 2 + (h)) * HTB)
#define PG8_STAGE(bufoff, gbase, voff) do { _Pragma("unroll") for (int _i = 0; _i < 2; ++_i) \
        __builtin_amdgcn_global_load_lds((const unsigned*)((const char*)(gbase) + (voff)[_i]), (PG8_LAS unsigned*)(lds + (bufoff) + ldsw + _i * 8192), 16, 0, 0); } while (0)
#define PG8_LDA(dst, b, h) do { _Pragma("unroll") for (int m = 0; m < 4; ++m) _Pragma("unroll") for (int k = 0; k < 2; ++k) dst[m][k] = *(const PG8_LAS bf16x8*)(lds + PG8_SA(b, h) + aoff + m * 2048 + k * 1024); } while (0)
#define PG8_LDB(dst, b, h) do { _Pragma("unroll") for (int n = 0; n < 2; ++n) _Pragma("unroll") for (int k = 0; k < 2; ++k) dst[n][k] = *(const PG8_LAS bf16x8*)(lds + PG8_SB(b, h) + boff + n * 2048 + k * 1024); } while (0)
#define PG8_MMA(ai, bj, At, Bt) do { __builtin_amdgcn_s_setprio(1); _Pragma("unroll") for (int m = 0; m < 4; ++m) _Pragma("unroll") for (int n = 0; n < 2; ++n) _Pragma("unroll") for (int k = 0; k < 2; ++k) \
        acc[ai][bj][m][n] = __builtin_amdgcn_mfma_f32_16x16x32_bf16(Bt[n][k], At[m][k], acc[ai][bj][m][n], 0, 0, 0); __builtin_amdgcn_s_setprio(0); } while (0)
#define PG8_WAIT_V(n) asm volatile("s_waitcnt vmcnt(" #n ")" ::: "memory")
#define PG8_WAIT_L(n) asm volatile("s_waitcnt lgkmcnt(" #n ")" ::: "memory")
#define PG8_BAR __builtin_amdgcn_s_barrier()
#define PG8_SCHED __builtin_amdgcn_sched_barrier(0)
    Unit cur, nxt; int ui = 0;
    if (!S.next(0, cur)) return;
    if constexpr (Epi::KSPLIT) E.prep(cur, 0, tid);
    f32x4 acc[2][2][4][2];
#pragma unroll
    for (int a = 0; a < 2; ++a)
#pragma unroll
        for (int b = 0; b < 2; ++b)
#pragma unroll
            for (int m = 0; m < 4; ++m)
#pragma unroll
                for (int n = 0; n < 2; ++n) acc[a][b][m][n] = (f32x4){0.f, 0.f, 0.f, 0.f};
    bf16x8 At[4][2], B0[2][2], B1[2][2];
    const char* cA = (const char*)g.A + (size_t)cur.pm * tstep; const char* cB = (const char*)g.Bt + (size_t)cur.pn * tstep;
    S.a_ready(cur);
    if constexpr (SP2) {
        PG8_STAGE(PG8_SB(0, 0), cB, voffB); PG8_STAGE(PG8_SB(0, 1), cB + hstep, voffB); PG8_STAGE(PG8_SA(0, 0), cA, voffA); PG8_STAGE(PG8_SA(0, 1), cA + hstep, voffA);
        if (wr == 1) PG8_BAR;
        PG8_WAIT_V(2); PG8_BAR;
        PG8_STAGE(PG8_SB(1, 0), cB + kstep, voffB); PG8_STAGE(PG8_SA(1, 0), cA + kstep, voffA); PG8_STAGE(PG8_SB(1, 1), cB + hstep + kstep, voffB);
        PG8_WAIT_V(6); PG8_BAR;
    } else {
        PG8_STAGE(PG8_SB(0, 0), cB, voffB); PG8_STAGE(PG8_SA(0, 0), cA, voffA); PG8_STAGE(PG8_SB(0, 1), cB + hstep, voffB); PG8_STAGE(PG8_SA(0, 1), cA + hstep, voffA);
        if (wr == 1) PG8_BAR;
        PG8_WAIT_V(4); PG8_BAR;
        PG8_STAGE(PG8_SB(1, 0), cB + kstep, voffB); PG8_STAGE(PG8_SA(1, 0), cA + kstep, voffA); PG8_STAGE(PG8_SB(1, 1), cB + hstep + kstep, voffB);
        PG8_WAIT_V(6); PG8_BAR;
    }
    for (;;) {
        const bool has_next = S.next(ui + 1, nxt);
        const char* nA = has_next ? (const char*)g.A + (size_t)nxt.pm * tstep : cA; const char* nB = has_next ? (const char*)g.Bt + (size_t)nxt.pn * tstep : cB;
        for (int t = 0; t < nt; t += 2) {
            if constexpr (Epi::KSPLIT) { if (t == (nt >> 1)) E.mid(acc, ui, wr, fr); }
            const bool last = (t == nt - 2);
            const char* a1 = cA + (size_t)(t + 1) * kstep;
            const char* a2 = last ? nA : cA + (size_t)(t + 2) * kstep; const char* b2 = last ? nB : cB + (size_t)(t + 2) * kstep;
            const char* a3 = a2 + kstep; const char* b3 = b2 + kstep;
            if (last && has_next) S.a_ready(nxt);
            if constexpr (SP2) {
            PG8_LDB(B0, 0, 0); PG8_LDB(B1, 0, 1); PG8_SCHED; PG8_LDA(At, 0, 0); PG8_STAGE(PG8_SA(1, 1), a1 + hstep, voffA);
            PG8_WAIT_V(8); PG8_WAIT_L(0); PG8_BAR; PG8_MMA(0, 0, At, B0); PG8_MMA(0, 1, At, B1); PG8_BAR; PG8_SCHED;
            PG8_LDA(At, 0, 1); PG8_STAGE(PG8_SB(0, 0), b2, voffB); PG8_STAGE(PG8_SB(0, 1), b2 + hstep, voffB); PG8_STAGE(PG8_SA(0, 0), a2, voffA);
            PG8_WAIT_V(8); PG8_WAIT_L(0); PG8_BAR; PG8_MMA(1, 0, At, B0); PG8_MMA(1, 1, At, B1); PG8_BAR; PG8_SCHED;
            PG8_LDB(B0, 1, 0); PG8_LDB(B1, 1, 1); PG8_SCHED; PG8_LDA(At, 1, 0); PG8_STAGE(PG8_SA(0, 1), a2 + hstep, voffA);
            PG8_WAIT_V(8); PG8_WAIT_L(0); PG8_BAR; PG8_MMA(0, 0, At, B0); PG8_MMA(0, 1, At, B1); PG8_BAR; PG8_SCHED;
            PG8_LDA(At, 1, 1); PG8_STAGE(PG8_SB(1, 0), b3, voffB); PG8_STAGE(PG8_SB(1, 1), b3 + hstep, voffB); PG8_STAGE(PG8_SA(1, 0), a3, voffA);
            PG8_WAIT_V(8); PG8_WAIT_L(0); PG8_BAR; PG8_MMA(1, 0, At, B0); PG8_MMA(1, 1, At, B1); PG8_BAR; PG8_SCHED;
            } else {
            PG8_LDB(B0, 0, 0); PG8_SCHED; PG8_LDA(At, 0, 0); PG8_STAGE(PG8_SA(1, 1), a1 + hstep, voffA);
            PG8_WAIT_L(8); PG8_BAR; PG8_WAIT_L(0); PG8_MMA(0, 0, At, B0); PG8_BAR; PG8_SCHED;
            PG8_LDB(B1, 0, 1); PG8_STAGE(PG8_SB(0, 0), b2, voffB);
            PG8_BAR; PG8_WAIT_L(0); PG8_MMA(0, 1, At, B1); PG8_BAR;
            PG8_LDA(At, 0, 1); PG8_STAGE(PG8_SA(0, 0), a2, voffA);
            PG8_BAR; PG8_WAIT_L(0); PG8_MMA(1, 0, At, B0); PG8_BAR; PG8_SCHED;
            PG8_STAGE(PG8_SB(0, 1), b2 + hstep, voffB);
            PG8_WAIT_V(6); PG8_BAR; PG8_MMA(1, 1, At, B1); PG8_BAR;
            PG8_LDB(B0, 1, 0); PG8_SCHED; PG8_LDA(At, 1, 0); PG8_STAGE(PG8_SA(0, 1), a2 + hstep, voffA);
            PG8_WAIT_L(8); PG8_BAR; PG8_WAIT_L(0); PG8_MMA(0, 0, At, B0); PG8_BAR; PG8_SCHED;
            PG8_LDB(B1, 1, 1); PG8_STAGE(PG8_SB(1, 0), b3, voffB);
            PG8_BAR; PG8_WAIT_L(0); PG8_MMA(0, 1, At, B1); PG8_BAR;
            PG8_LDA(At, 1, 1); PG8_STAGE(PG8_SA(1, 0), a3, voffA);
            PG8_BAR; PG8_WAIT_L(0); PG8_MMA(1, 0, At, B0); PG8_BAR; PG8_SCHED;
            PG8_STAGE(PG8_SB(1, 1), b3 + hstep, voffB);
            PG8_WAIT_V(6); PG8_BAR; PG8_MMA(1, 1, At, B1); PG8_BAR;
            }
        }
        if constexpr (ALIGN_EPI) { if (wr == 0) PG8_BAR; }
        if constexpr (!Epi::AFTER_DRAIN) { if constexpr (Epi::KSPLIT) E.epi_ks(acc, cur, ui, wr, wc, fr, fq); else E(acc, cur, wr, wc, fr, fq); S.done(cur); }
        if (!has_next) break;
#pragma unroll
        for (int a = 0; a < 2; ++a)
#pragma unroll
            for (int b = 0; b < 2; ++b)
#pragma unroll
                for (int m = 0; m < 4; ++m)
#pragma unroll
                    for (int n = 0; n < 2; ++n) acc[a][b][m][n] = (f32x4){0.f, 0.f, 0.f, 0.f};
        cur = nxt; cA = nA; cB = nB; ++ui;
        if constexpr (Epi::KSPLIT) E.prep(cur, ui, tid);
        if constexpr (ALIGN_EPI) { if (wr == 1) PG8_BAR; }
    }
    PG8_WAIT_V(0);
    if constexpr (!ALIGN_EPI) { if (wr == 0) PG8_BAR; }
    PG8_BAR;
    if constexpr (Epi::AFTER_DRAIN) { E.fused(acc, cur, wr, wc, fr, fq, lds, wid, lane); S.done(cur); }
#undef PG8_SA
#undef PG8_SB
#undef PG8_STAGE
#undef PG8_LDA
#undef PG8_LDB
#undef PG8_MMA
#undef PG8_WAIT_V
#undef PG8_WAIT_L
#undef PG8_BAR
#undef PG8_SCHED
}
}
#define LAS __attribute__((address_space(3)))
typedef unsigned short bf16;
typedef float f32x4 __attribute__((ext_vector_type(4)));
typedef float f32x16 __attribute__((ext_vector_type(16)));
typedef short bf16x8 __attribute__((ext_vector_type(8)));
typedef short s16x4 __attribute__((ext_vector_type(4)));
typedef unsigned v4u __attribute__((ext_vector_type(4)));
typedef unsigned v2u __attribute__((ext_vector_type(2)));

constexpr int NWAVES = 8, NTHREADS = 512;
constexpr int T_P = 8192, T_S = 16384, T = T_P + T_S, D = 2048, PW = 5120, FF = 5632, DEPTH = 4;
constexpr int C_U = 0, C_VA = 1024, C_Q = 2048, C_K = 3072, C_V = 4096;
constexpr float EPS = 1e-6f;
constexpr float QSCALE = 0.08838834764831845f * 1.4426950408889634f;

constexpr size_t MiB = 1u << 20;
constexpr size_t WS_CTL = 0;
constexpr size_t WS_ROPE = 1 * MiB;
constexpr size_t WS_WSB = 3 * MiB;
constexpr size_t WS_SSA = 4 * MiB;
constexpr size_t WS_SSB = 5 * MiB;
constexpr size_t WS_SSM = 6 * MiB;
constexpr size_t WS_LSE = 9 * MiB;
constexpr size_t WS_WIN = 12 * MiB;
constexpr size_t WS_WO = 92 * MiB;
constexpr size_t WS_WGU = 124 * MiB;
constexpr size_t WS_WDN = 300 * MiB;
constexpr size_t WS_H = 388 * MiB;
constexpr size_t WS_R1 = 484 * MiB;
constexpr size_t WS_MIX = 748 * MiB;
constexpr size_t WS_X = 844 * MiB;
constexpr size_t WS_END = 940 * MiB;
constexpr int LDS_BYTES = 147456, MISC_OFF = 131072 + 12288;

__device__ __forceinline__ unsigned cvtpk(float lo, float hi) { unsigned r; asm volatile("v_cvt_pk_bf16_f32 %0, %1, %2" : "=v"(r) : "v"(lo), "v"(hi)); return r; }
__device__ __forceinline__ float bflo(unsigned w) { return __uint_as_float(w << 16); }
__device__ __forceinline__ float bfhi(unsigned w) { return __uint_as_float(w & 0xffff0000u); }
__device__ __forceinline__ float wave_sum(float v) {
#pragma unroll
    for (int o = 1; o < 64; o <<= 1) v += __shfl_xor(v, o);
    return v;
}

struct Args { const float* in[16]; float* out; unsigned char* ws; };

__device__ __forceinline__ void transpose_item(const float* W, int K, int N, bf16* WT, int mode, LAS float* scr, int item, int lane, const float* kscale = nullptr) {
    const int nblk = N / 32, kb = item / nblk, nb = item % nblk, k0 = 64 * kb, n0 = 32 * nb;
    const int drow0 = mode == 0 ? n0 : (256 * (n0 >> 7) + (n0 & 127) + (mode == 2 ? 128 : 0));
#pragma unroll 8
    for (int i = 0; i < 32; ++i) { const int kk = 2 * i + (lane >> 5); float w = W[(size_t)(k0 + kk) * N + n0 + (lane & 31)]; if (kscale) w *= kscale[k0 + kk]; scr[kk * 33 + (lane & 31)] = w; }
    asm volatile("s_waitcnt lgkmcnt(0)" ::: "memory");
    const int c = lane & 7;
#pragma unroll
    for (int j = 0; j < 4; ++j) { const int n = (lane >> 3) + 8 * j; const LAS float* s = scr + (8 * c) * 33 + n;
        v4u o; o.x = cvtpk(s[0 * 33], s[1 * 33]); o.y = cvtpk(s[2 * 33], s[3 * 33]); o.z = cvtpk(s[4 * 33], s[5 * 33]); o.w = cvtpk(s[6 * 33], s[7 * 33]);
        *(v4u*)(WT + (size_t)(drow0 + n) * K + k0 + 8 * c) = o; }
    asm volatile("s_waitcnt lgkmcnt(0)" ::: "memory");
}

constexpr int CV_IN = (D / 64) * (PW / 32), CV_O = (D / 64) * (D / 32), CV_G = (D / 64) * (FF / 32), CV_D = (FF / 64) * (D / 32);
constexpr int CV_PER_L = CV_IN + CV_O + 2 * CV_G + CV_D;
constexpr int CV_WSTRIDE = 2 * 64 * 33 * 4;
struct CvDesc { const float* W; bf16* WT; const float* ks; int K, N, k0, n0, drow0; };
__device__ __forceinline__ CvDesc cv_desc(const Args& a, int l, int r) {
    unsigned char* ws = a.ws; CvDesc d; int mode = 0; d.ks = nullptr;
    if (r < CV_IN) { d.W = a.in[3] + (size_t)l * D * PW; d.K = D; d.N = PW; d.WT = (bf16*)(ws + WS_WIN) + (size_t)l * PW * D; }
    else if ((r -= CV_IN) < CV_O) { d.W = a.in[9] + (size_t)l * D * D; d.K = D; d.N = D; d.WT = (bf16*)(ws + WS_WO) + (size_t)l * D * D;
        const int kb_ = r / (D / 32); d.ks = (kb_ < 16 ? a.in[7] + (size_t)l * 1024 : a.in[8] + (size_t)l * 1024 - 1024); }
    else if ((r -= CV_O) < CV_G) { d.W = a.in[12] + (size_t)l * D * FF; d.K = D; d.N = FF; d.WT = (bf16*)(ws + WS_WGU) + (size_t)l * 2 * FF * D; mode = 1; }
    else if ((r -= CV_G) < CV_G) { d.W = a.in[13] + (size_t)l * D * FF; d.K = D; d.N = FF; d.WT = (bf16*)(ws + WS_WGU) + (size_t)l * 2 * FF * D; mode = 2; }
    else { r -= CV_G; d.W = a.in[14] + (size_t)l * FF * D; d.K = FF; d.N = D; d.WT = (bf16*)(ws + WS_WDN) + (size_t)l * D * FF; }
    const int nblk = d.N / 32, kb = r / nblk, nb = r % nblk; d.k0 = 64 * kb; d.n0 = 32 * nb;
    d.drow0 = mode == 0 ? d.n0 : (256 * (d.n0 >> 7) + (d.n0 & 127) + (mode == 2 ? 128 : 0));
    return d;
}
__device__ __forceinline__ void cv_load(const CvDesc& d, float (&r)[32], int lane) {
#pragma unroll
    for (int i = 0; i < 32; ++i) { const int kk = 2 * i + (lane >> 5); r[i] = d.W[(size_t)(d.k0 + kk) * d.N + d.n0 + (lane & 31)]; }
}
__device__ __forceinline__ void cv_lds(const CvDesc& d, const float (&r)[32], LAS float* scr, int lane) {
#pragma unroll
    for (int i = 0; i < 32; ++i) { const int kk = 2 * i + (lane >> 5); float w = r[i]; if (d.ks) w *= d.ks[d.k0 + kk]; scr[kk * 33 + (lane & 31)] = w; }
}
__device__ __forceinline__ void cv_store(const CvDesc& d, const LAS float* scr, int lane) {
    const int c = lane & 7;
#pragma unroll
    for (int j = 0; j < 4; ++j) { const int n = (lane >> 3) + 8 * j; const LAS float* s = scr + (8 * c) * 33 + n;
        v4u o; o.x = cvtpk(s[0 * 33], s[1 * 33]); o.y = cvtpk(s[2 * 33], s[3 * 33]); o.z = cvtpk(s[4 * 33], s[5 * 33]); o.w = cvtpk(s[6 * 33], s[7 * 33]);
        *(v4u*)(d.WT + (size_t)(d.drow0 + n) * d.K + d.k0 + 8 * c) = o; }
}
__device__ __forceinline__ void convert_items(const Args& a, LAS unsigned char* lds, int l, int lo, int hi, int gwx, int NW, int wave, int lane) {
    LAS float* scr0 = (LAS float*)(lds + wave * CV_WSTRIDE); LAS float* scr1 = scr0 + 64 * 33;
    for (int it = lo + gwx; it < hi; it += 2 * NW) {
        const bool two = it + NW < hi;
        const CvDesc d0 = cv_desc(a, l, it), d1 = cv_desc(a, l, two ? it + NW : it);
        float r0[32], r1[32];
        cv_load(d0, r0, lane); if (two) cv_load(d1, r1, lane);
        cv_lds(d0, r0, scr0, lane); if (two) cv_lds(d1, r1, scr1, lane);
        asm volatile("s_waitcnt lgkmcnt(0)" ::: "memory");
        cv_store(d0, scr0, lane); if (two) cv_store(d1, scr1, lane);
        asm volatile("s_waitcnt lgkmcnt(0)" ::: "memory");
    }
}
__device__ __forceinline__ void convert_in_idle_slot(const Args& a, LAS unsigned char* lds, int l_next, int part, int nwg, int G, int bid, int wave, int lane) {
    const int first_idle = nwg % G;
    const int nidle = first_idle ? G - first_idle : G;
    if (first_idle && bid < first_idle) return;
    const int half = CV_PER_L / 2;
    convert_items(a, lds, l_next, part ? half : 0, part ? CV_PER_L : half, (bid - first_idle) * NWAVES + wave, nidle * NWAVES, wave, lane);
}
__device__ __forceinline__ void prologue_phase(const Args& a, LAS unsigned char* lds, int gw, int NGW, int wave, int lane) {
    unsigned char* ws = a.ws;
    convert_items(a, lds, 0, 0, CV_PER_L, gw, NGW, wave, lane);
    { const float* src = a.in[5]; bf16* dst = (bf16*)(ws + WS_WSB); const int n4 = DEPTH * 8 * 128 * 128 / 4;
      for (int i = gw * 64 + lane; i < n4; i += NGW * 64) { const f32x4 v = ((const f32x4*)src)[i]; v2u o; o.x = cvtpk(v[0], v[1]); o.y = cvtpk(v[2], v[3]); ((v2u*)dst)[i] = o; } }
    { float* tab = (float*)(ws + WS_ROPE);
      for (int i = gw * 64 + lane; i < 16384 * 16; i += NGW * 64) { const int pos = i >> 4, f = i & 15;
          const float inv = (float)pow(500000.0, -(double)f / 16.0); const float ang = (float)pos * inv;
          tab[pos * 32 + f] = (float)cos((double)ang); tab[pos * 32 + 16 + f] = (float)sin((double)ang); } }
}

template <bool FIRST, bool LAST>
__device__ __forceinline__ void resnorm_phase(const Args& a, const float* g_post, const float* g_next, int gw, int NGW, int lane) {
    unsigned char* ws = a.ws; bf16* X = (bf16*)(ws + WS_X); bf16* H = (bf16*)(ws + WS_H);
    const bf16* MIXb = (const bf16*)(ws + WS_MIX); const float* ssM = (const float*)(ws + WS_SSM);
    constexpr int R = FIRST ? 2 : 4;
    f32x4 gp[8], gn[8];
#pragma unroll
    for (int j = 0; j < 8; ++j) { gp[j] = FIRST ? (f32x4){0.f, 0.f, 0.f, 0.f} : ((const f32x4*)g_post)[lane + 64 * j]; gn[j] = LAST ? (f32x4){0.f, 0.f, 0.f, 0.f} : ((const f32x4*)g_next)[lane + 64 * j]; }
    for (int row0 = gw; row0 < T; row0 += R * NGW) {
        v2u xv[R][8], m[R][8]; f32x4 vin[FIRST ? R : 1][8]; float ssp[R];
#pragma unroll
        for (int q = 0; q < R; ++q) { const int row = row0 + q * NGW; if (row < T) {
            if (FIRST) {
                const f32x4* src = (const f32x4*)(row < T_P ? a.in[0] + (size_t)row * D : a.in[1] + (size_t)(row - T_P) * D);
#pragma unroll
                for (int j = 0; j < 8; ++j) vin[FIRST ? q : 0][j] = src[lane + 64 * j];
            } else {
                const v2u* xr = (const v2u*)(X + (size_t)row * D); const v2u* mp = (const v2u*)(MIXb + (size_t)row * D);
#pragma unroll
                for (int j = 0; j < 8; ++j) { xv[q][j] = xr[lane + 64 * j]; m[q][j] = mp[lane + 64 * j]; }
                ssp[q] = lane < 32 ? ssM[(size_t)row * 32 + lane] : 0.f;
            } } }
#pragma unroll
        for (int q = 0; q < R; ++q) { const int row = row0 + q * NGW; if (row < T) {
            f32x4 v[8];
            if (FIRST) {
#pragma unroll
                for (int j = 0; j < 8; ++j) v[j] = vin[FIRST ? q : 0][j];
            } else {
                const float rinv = 1.0f / sqrtf(wave_sum(ssp[q]) * (1.0f / D) + EPS);
#pragma unroll
                for (int j = 0; j < 8; ++j) {
                    v[j][0] = bflo(xv[q][j].x) + bflo(m[q][j].x) * rinv * gp[j][0]; v[j][1] = bfhi(xv[q][j].x) + bfhi(m[q][j].x) * rinv * gp[j][1];
                    v[j][2] = bflo(xv[q][j].y) + bflo(m[q][j].y) * rinv * gp[j][2]; v[j][3] = bfhi(xv[q][j].y) + bfhi(m[q][j].y) * rinv * gp[j][3]; }
            }
            if (LAST) {
                f32x4* yo = (f32x4*)(a.out + (size_t)row * D);
#pragma unroll
                for (int j = 0; j < 8; ++j) yo[lane + 64 * j] = v[j];
            } else {
                v2u* xo = (v2u*)(X + (size_t)row * D); v2u* ho = (v2u*)(H + (size_t)row * D); float s2 = 0.f;
#pragma unroll
                for (int j = 0; j < 8; ++j) { v2u o; o.x = cvtpk(v[j][0], v[j][1]); o.y = cvtpk(v[j][2], v[j][3]); xo[lane + 64 * j] = o;
                    s2 += (v[j][0] * v[j][0] + v[j][1] * v[j][1]) + (v[j][2] * v[j][2] + v[j][3] * v[j][3]); }
                const float r2 = 1.0f / sqrtf(wave_sum(s2) * (1.0f / D) + EPS);
#pragma unroll
                for (int j = 0; j < 8; ++j) { v2u o; o.x = cvtpk(v[j][0] * r2 * gn[j][0], v[j][1] * r2 * gn[j][1]); o.y = cvtpk(v[j][2] * r2 * gn[j][2], v[j][3] * r2 * gn[j][3]); ho[lane + 64 * j] = o; }
            } } }
    }
}

__device__ __forceinline__ void mnorm_phase(const Args& a, const float* gA, const float* gB, int gw, int NGW, int lane) {
    unsigned char* ws = a.ws; bf16* MG = (bf16*)(ws + WS_H); const float* ssA = (const float*)(ws + WS_SSA); const float* ssB = (const float*)(ws + WS_SSB);
    for (int row = gw; row < T; row += NGW) {
        float p = lane < 8 ? ssA[(size_t)lane * T + row] : (lane < 16 ? ssB[(size_t)(lane - 8) * T + row] : 0.f);
        p += __shfl_xor(p, 1); p += __shfl_xor(p, 2); p += __shfl_xor(p, 4);
        const float sa = __shfl(p, 0), sb = __shfl(p, 8);
        const float rA = 1.0f / sqrtf(sa * (1.0f / 1024.0f) + EPS), rB = 1.0f / sqrtf(sb * (1.0f / 1024.0f) + EPS);
        v4u* rp = (v4u*)(MG + (size_t)row * D);
#pragma unroll
        for (int j = 0; j < 4; ++j) {
            const int ch = lane + 64 * j; v4u w = rp[ch];
            const float r = j < 2 ? rA : rB; const float* g = (j < 2 ? gA : gB) + (ch & 127) * 8;
            const f32x4 g0 = *(const f32x4*)g, g1 = *(const f32x4*)(g + 4);
            v4u o; o.x = cvtpk(bflo(w.x) * r * g0[0], bfhi(w.x) * r * g0[1]); o.y = cvtpk(bflo(w.y) * r * g0[2], bfhi(w.y) * r * g0[3]);
            o.z = cvtpk(bflo(w.z) * r * g1[0], bfhi(w.z) * r * g1[1]); o.w = cvtpk(bflo(w.w) * r * g1[2], bfhi(w.w) * r * g1[3]);
            rp[ch] = o;
        }
    }
}

constexpr int GM_LDT = 136;
__device__ __forceinline__ void gmlp_item(const Args& a, int layer, int chunk, int g, LAS unsigned char* lds, int tid_in, int wave, int lane_in) {
    int tid = tid_in; asm volatile("" : "+v"(tid)); const int lane = tid & 63; (void)lane_in;
    unsigned char* ws = a.ws; const bf16* PROJ = (const bf16*)(ws + WS_R1); bf16* MG = (bf16*)(ws + WS_H);
    LAS bf16* Vt = (LAS bf16*)lds;
    LAS float* ssl = (LAS float*)(lds + (128 * GM_LDT + 64) * 2);
    const int R0 = chunk * 128;
    const int tq = wave & 3, chh = wave >> 2, hf = lane >> 5, l31 = lane & 31;
    const int t = 32 * tq + l31, row = R0 + t;
    bf16x8 bfr[8]; v2u uw[2][4];
    { const bf16* wsb = (const bf16*)(ws + WS_WSB) + ((size_t)(layer * 8 + g) * 128 + t) * 128 + 8 * hf;
#pragma unroll
      for (int ks = 0; ks < 8; ++ks) bfr[ks] = *(const bf16x8*)(wsb + 16 * ks);
      const bf16* up = PROJ + (size_t)row * PW + C_U + g * 128 + 64 * chh + 4 * hf;
#pragma unroll
      for (int cb = 0; cb < 2; ++cb)
#pragma unroll
          for (int g4 = 0; g4 < 4; ++g4) uw[cb][g4] = *(const v2u*)(up + 32 * cb + 8 * g4); }
    const float bias = a.in[6][(size_t)layer * 1024 + g * 128 + t];
    {
        const int s = tid >> 2, q = tid & 3;
        const v4u* vp = (const v4u*)(PROJ + (size_t)(R0 + s) * PW + C_VA + g * 128 + 32 * q);
        float x[32];
#pragma unroll
        for (int i = 0; i < 4; ++i) { const v4u w = vp[i]; x[8 * i + 0] = bflo(w.x); x[8 * i + 1] = bfhi(w.x); x[8 * i + 2] = bflo(w.y); x[8 * i + 3] = bfhi(w.y);
            x[8 * i + 4] = bflo(w.z); x[8 * i + 5] = bfhi(w.z); x[8 * i + 6] = bflo(w.w); x[8 * i + 7] = bfhi(w.w); }
        float sm = 0.f;
#pragma unroll
        for (int i = 0; i < 32; ++i) sm += x[i];
        sm += __shfl_xor(sm, 1); sm += __shfl_xor(sm, 2);
        const float mu = sm * (1.0f / 128.0f); float vq = 0.f;
#pragma unroll
        for (int i = 0; i < 32; ++i) { x[i] -= mu; vq += x[i] * x[i]; }
        vq += __shfl_xor(vq, 1); vq += __shfl_xor(vq, 2);
        const float rs = 1.0f / sqrtf(vq * (1.0f / 128.0f) + EPS);
        const f32x4* gn4 = (const f32x4*)(a.in[4] + (size_t)layer * 1024 + g * 128 + 32 * q);
        float gn[32];
#pragma unroll
        for (int i = 0; i < 8; ++i) { const f32x4 gv = gn4[i]; gn[4 * i] = gv[0]; gn[4 * i + 1] = gv[1]; gn[4 * i + 2] = gv[2]; gn[4 * i + 3] = gv[3]; }
#pragma unroll
        for (int i = 0; i < 32; i += 2) { const unsigned w = cvtpk(x[i] * rs * gn[i], x[i + 1] * rs * gn[i + 1]);
            Vt[(32 * q + i) * GM_LDT + 16 * q + s] = (bf16)(w & 0xffffu); Vt[(32 * q + i + 1) * GM_LDT + 16 * q + s] = (bf16)(w >> 16); }
    }
    __syncthreads();
    {
        f32x16 acc0, acc1;
#pragma unroll
        for (int i = 0; i < 16; ++i) { acc0[i] = 0.f; acc1[i] = 0.f; }
#pragma unroll
        for (int ks = 0; ks < 8; ++ks) {
            const bf16x8 a0 = *(const LAS bf16x8*)(Vt + (64 * chh + l31) * GM_LDT + 16 * (2 * chh) + 16 * ks + 8 * hf);
            const bf16x8 a1 = *(const LAS bf16x8*)(Vt + (64 * chh + 32 + l31) * GM_LDT + 16 * (2 * chh + 1) + 16 * ks + 8 * hf);
            acc0 = __builtin_amdgcn_mfma_f32_32x32x16_bf16(a0, bfr[ks], acc0, 0, 0, 0);
            acc1 = __builtin_amdgcn_mfma_f32_32x32x16_bf16(a1, bfr[ks], acc1, 0, 0, 0);
        }
        bf16* op = MG + (size_t)row * D + g * 128 + 64 * chh + 4 * hf;
        float ss = 0.f;
#pragma unroll
        for (int cb = 0; cb < 2; ++cb)
#pragma unroll
            for (int g4 = 0; g4 < 4; ++g4) {
                const v2u uwv = uw[cb][g4];
                float o0, o1, o2, o3;
                if (cb == 0) { o0 = bflo(uwv.x) * (acc0[4 * g4 + 0] + bias); o1 = bfhi(uwv.x) * (acc0[4 * g4 + 1] + bias); o2 = bflo(uwv.y) * (acc0[4 * g4 + 2] + bias); o3 = bfhi(uwv.y) * (acc0[4 * g4 + 3] + bias); }
                else         { o0 = bflo(uwv.x) * (acc1[4 * g4 + 0] + bias); o1 = bfhi(uwv.x) * (acc1[4 * g4 + 1] + bias); o2 = bflo(uwv.y) * (acc1[4 * g4 + 2] + bias); o3 = bfhi(uwv.y) * (acc1[4 * g4 + 3] + bias); }
                ss += (o0 * o0 + o1 * o1) + (o2 * o2 + o3 * o3);
                v2u ow; ow.x = cvtpk(o0, o1); ow.y = cvtpk(o2, o3);
                *(v2u*)(op + 32 * cb + 8 * g4) = ow;
            }
        ss += __shfl_xor(ss, 32);
        if (hf == 0) ssl[chh * 128 + t] = ss;
    }
    __syncthreads();
    if (tid < 128) ((float*)(ws + WS_SSA))[(size_t)g * T + R0 + tid] = ssl[tid] + ssl[128 + tid];
}

__device__ __forceinline__ unsigned voff_b(unsigned row, unsigned ch) { return 256u * row + 16u * (ch ^ (((row & 3) << 2) | ((row >> 2) & 3))); }
typedef short v4i16_t __attribute__((ext_vector_type(4)));
__device__ __forceinline__ s16x4 vtr(const LAS unsigned char* p) { return __builtin_bit_cast(s16x4, __builtin_amdgcn_ds_read_tr16_b64_v4i16((LAS v4i16_t*)p)); }

__device__ __forceinline__ void glds16(const void* gsrc, unsigned lds_dst) { unsigned keep;
    asm volatile("s_mov_b32 %0, m0\n\ts_mov_b32 m0, %2\n\ts_nop 0\n\tglobal_load_lds_dwordx4 %1, off\n\ts_mov_b32 m0, %0" : "=&s"(keep) : "v"(gsrc), "s"(lds_dst) : "memory"); }
__device__ __forceinline__ void glds16s(const void* sbase, unsigned voff, unsigned lds_dst) { unsigned keep;
    asm volatile("s_mov_b32 %0, m0\n\ts_mov_b32 m0, %3\n\ts_nop 0\n\tglobal_load_lds_dwordx4 %1, %2\n\ts_mov_b32 m0, %0" : "=&s"(keep) : "v"(voff), "s"(sbase), "s"(lds_dst) : "memory"); }
#define ATT_DMA_FAST(FIRST, COLBASE, BUF) do { \
        const bf16* sb_ = PROJ + (size_t)(seq_base + r + dd * (FIRST)) * PW + (COLBASE) + h * 128; \
        const unsigned l0_ = (unsigned)__builtin_amdgcn_readfirstlane((int)(unsigned)(uintptr_t)(BUF)); \
        _Pragma("unroll") for (int i_ = 0; i_ < 8; ++i_) glds16s(sb_ + (size_t)i_ * 4 * dd * PW, voffs[i_ & 3], l0_ + 1024u * i_); \
    } while (0)
#define ATT_DMA_ANY(FIRST, COLBASE, BUF) do { if (edge) ATT_DMA(FIRST, COLBASE, BUF); else ATT_DMA_FAST(FIRST, COLBASE, BUF); } while (0)
#define ATT_DMA(FIRST, COLBASE, BUF) do { \
        int f0_ = (FIRST); asm volatile("" : "+s"(f0_)); \
        _Pragma("unroll") for (int i_ = 0; i_ < 8; ++i_) { const int row_ = 4 * i_ + (lane >> 4); int kj_ = f0_ + row_; kj_ = kj_ < 0 ? 0 : (kj_ >= L ? L - 1 : kj_); \
            const int ch_ = (lane & 15) ^ (((row_ & 3) << 2) | ((row_ >> 2) & 3)); \
            glds16(PROJ + (size_t)(seq_base + r + dd * kj_) * PW + (COLBASE) + h * 128 + 8 * ch_, (unsigned)__builtin_amdgcn_readfirstlane((int)(unsigned)(uintptr_t)((BUF) + 1024 * i_))); } \
    } while (0)
#define ATT_ROWFRAGS(DST, BUF) do { _Pragma("unroll") for (int s_ = 0; s_ < 8; ++s_) DST[s_] = *(const LAS bf16x8*)((BUF) + voff_b(l31, 2 * s_ + hf)); } while (0)
#define ATT_SOFTMAX_PV(KB, VBUF, WAITV) do { \
        if ((KB) == 0) { _Pragma("unroll") for (int i = 0; i < 16; ++i) { if ((i & 3) + 8 * (i >> 2) < lm) S[i] = -1e30f; } }            \
        else if ((KB) == 4) { _Pragma("unroll") for (int i = 0; i < 16; ++i) { if ((i & 3) + 8 * (i >> 2) > lm) S[i] = -1e30f; } }     \
        if (edge) { _Pragma("unroll") for (int i = 0; i < 16; ++i) { const int kj = J0 - 64 + 32 * (KB) + 4 * hf + (i & 3) + 8 * (i >> 2); if (kj < 0 || kj >= L) S[i] = -1e30f; } } \
        float bm = S[0]; \
        _Pragma("unroll") for (int i = 1; i < 16; ++i) bm = fmaxf(bm, S[i]); \
        bm = fmaxf(bm, __shfl_xor(bm, 32)); \
        const float mnew = fmaxf(mrun, bm); \
        const float alpha = __builtin_amdgcn_exp2f(mrun - mnew); \
        mrun = mnew; \
        float ps = 0.f; \
        _Pragma("unroll") for (int i = 0; i < 16; ++i) { S[i] = __builtin_amdgcn_exp2f(S[i] - mnew); ps += S[i]; } \
        lsum = lsum * alpha + ps; \
        _Pragma("unroll") for (int db = 0; db < 4; ++db) _Pragma("unroll") for (int i = 0; i < 16; ++i) O[db][i] *= alpha; \
        bf16x8 pf[2]; \
        _Pragma("unroll") for (int j = 0; j < 2; ++j) { v4u w; w.x = cvtpk(S[8 * j + 0], S[8 * j + 1]); w.y = cvtpk(S[8 * j + 2], S[8 * j + 3]); w.z = cvtpk(S[8 * j + 4], S[8 * j + 5]); w.w = cvtpk(S[8 * j + 6], S[8 * j + 7]); \
            pf[j] = __builtin_bit_cast(bf16x8, w); } \
        WAITV; \
        _Pragma("unroll") for (int db = 0; db < 4; ++db) _Pragma("unroll") for (int j = 0; j < 2; ++j) { \
                const s16x4 lo = vtr((VBUF) + tb[0][db] + 4096 * j); \
                const s16x4 hi = vtr((VBUF) + tb[1][db] + 4096 * j); \
                bf16x8 vf; vf[0] = lo[0]; vf[1] = lo[1]; vf[2] = lo[2]; vf[3] = lo[3]; vf[4] = hi[0]; vf[5] = hi[1]; vf[6] = hi[2]; vf[7] = hi[3]; \
                O[db] = __builtin_amdgcn_mfma_f32_32x32x16_bf16(vf, pf[j], O[db], 0, 0, 0); } \
    } while (0)
__device__ __forceinline__ void attn_wave_tile(const bf16* PROJ, int seq_base, int L, int dd, int r, int J0, int h, LAS unsigned char* vl, bf16* Oscr, float* lse_scr, int P0, int lane, int rot) {
    const int hf = lane >> 5, l31 = lane & 31;
    const bool edge = (J0 < 64) || (J0 + 96 > L);
    const int lm = l31 - 4 * hf;
    LAS unsigned char* kimg = vl; LAS unsigned char* vimg = vl + 8192;
    unsigned voffs[4];
    { const int q_ = lane >> 4;
#pragma unroll
      for (int k = 0; k < 4; ++k) voffs[k] = 2u * (unsigned)(q_ * dd * PW + 8 * ((lane & 15) ^ ((q_ << 2) | k))); }
    bf16x8 qf[8];
    ATT_DMA_FAST(J0, C_Q, kimg);
    asm volatile("s_waitcnt vmcnt(0)" ::: "memory");
    ATT_ROWFRAGS(qf, kimg);
    asm volatile("s_waitcnt lgkmcnt(0)" ::: "memory");
    const int kb0 = __builtin_amdgcn_readfirstlane((5 - rot) % 5);
    ATT_DMA_ANY(J0 - 64 + 32 * kb0, C_K, kimg); ATT_DMA_ANY(J0 - 64 + 32 * kb0, C_V, vimg);
    f32x16 O[4];
#pragma unroll
    for (int db = 0; db < 4; ++db)
#pragma unroll
        for (int i = 0; i < 16; ++i) O[db][i] = 0.f;
    float mrun = -1e30f, lsum = 0.f;
    unsigned tb[2][4];
    { const int blk = (lane >> 4) & 1, q4 = (lane & 15) >> 2, p4 = lane & 3;
#pragma unroll
      for (int t = 0; t < 2; ++t)
#pragma unroll
          for (int db = 0; db < 4; ++db) tb[t][db] = 256u * (4 * hf + q4 + 8 * t) + 64u * (db ^ q4) + 16u * ((2 * blk + (p4 >> 1)) ^ (hf + 2 * t)) + 8u * (p4 & 1); }
#pragma unroll 1
    for (int t = 0; t < 5; ++t) {
        const int kb = __builtin_amdgcn_readfirstlane((t + 5 - rot) % 5), kbn = __builtin_amdgcn_readfirstlane((t + 6 - rot) % 5);
        asm volatile("s_waitcnt vmcnt(8)" ::: "memory");
        f32x16 S;
#pragma unroll
        for (int i = 0; i < 16; ++i) S[i] = 0.f;
#pragma unroll
        for (int kk = 0; kk < 8; ++kk) { const bf16x8 kfr = *(const LAS bf16x8*)(kimg + voff_b(l31, 2 * kk + hf)); S = __builtin_amdgcn_mfma_f32_32x32x16_bf16(kfr, qf[kk], S, 0, 0, 0); }
        asm volatile("s_waitcnt lgkmcnt(0)" ::: "memory");
        if (t < 4) ATT_DMA_ANY(J0 - 64 + 32 * kbn, C_K, kimg);
        if (t < 4) { ATT_SOFTMAX_PV(kb, vimg, asm volatile("s_waitcnt vmcnt(8)" ::: "memory")); }
        else       { ATT_SOFTMAX_PV(kb, vimg, asm volatile("s_waitcnt vmcnt(0)" ::: "memory")); }
        asm volatile("s_waitcnt lgkmcnt(0)" ::: "memory");
        if (t < 4) ATT_DMA_ANY(J0 - 64 + 32 * kbn, C_V, vimg);
    }
    const float ltot = lsum + __shfl_xor(lsum, 32);
    const float inv = 1.0f / ltot;
    const int ql = r + dd * (J0 + l31) - P0;
    bf16* op = Oscr + (size_t)ql * 128 + 4 * hf;
#pragma unroll
    for (int db = 0; db < 4; ++db)
#pragma unroll
        for (int g4 = 0; g4 < 4; ++g4) { v2u w; w.x = cvtpk(O[db][4 * g4 + 0] * inv, O[db][4 * g4 + 1] * inv); w.y = cvtpk(O[db][4 * g4 + 2] * inv, O[db][4 * g4 + 3] * inv);
            *(v2u*)(op + 32 * db + 8 * g4) = w; }
    if (hf == 0) lse_scr[ql] = mrun + __builtin_amdgcn_logf(ltot);
}

__device__ __forceinline__ void attn_item(const Args& a, int h, int blk512, LAS unsigned char* lds, int tid_in, int wave, int lane_in) {
    int tid = tid_in; asm volatile("" : "+v"(tid)); int lane = tid & 63; (void)lane_in;
    unsigned char* ws = a.ws; const bf16* PROJ = (const bf16*)(ws + WS_R1); bf16* MG = (bf16*)(ws + WS_H);
    bf16* Oscr = (bf16*)(ws + WS_MIX) + (size_t)blockIdx.x * (3 * 512 * 128);
    float* lse = (float*)(ws + WS_LSE) + (size_t)blockIdx.x * (3 * 512);
    const int row0 = blk512 * 512;
    const int seq_base = row0 < T_P ? 0 : T_P, S = row0 < T_P ? T_P : T_S, P0 = row0 - seq_base;
    LAS unsigned char* vl = lds + wave * 16384;
#pragma unroll 1
    for (int p = 0; p < 3; ++p) {
        const int dd = p == 0 ? 1 : (p == 1 ? 4 : 16), tpr = 16 / dd, L = S / dd;
#pragma unroll 1
        for (int tt = 0; tt < 2; ++tt) {
            const int tau = wave + 8 * tt, r = tau / tpr, w = tau % tpr;
            attn_wave_tile(PROJ, seq_base, L, dd, r, P0 / dd + 32 * w, h, vl, Oscr + (size_t)p * 512 * 128, lse + p * 512, P0, lane, w % 5);
        }
    }
    __syncthreads();
    asm volatile("" : "+v"(lane));
    float* ssB = (float*)(ws + WS_SSB) + (size_t)h * T;
#pragma unroll 4
    for (int st = 0; st < 16; ++st) {
        const int pl = st * 32 + wave * 4 + (lane >> 4), ch = lane & 15;
        const float l0 = lse[pl], l1 = lse[512 + pl], l2 = lse[1024 + pl];
        const float mx = fmaxf(l0, fmaxf(l1, l2));
        float w0 = __builtin_amdgcn_exp2f(l0 - mx), w1 = __builtin_amdgcn_exp2f(l1 - mx), w2 = __builtin_amdgcn_exp2f(l2 - mx);
        const float iw = 1.0f / (w0 + w1 + w2); w0 *= iw; w1 *= iw; w2 *= iw;
        const v4u a0 = *(const v4u*)(Oscr + (size_t)pl * 128 + 8 * ch), a1 = *(const v4u*)(Oscr + (size_t)(512 + pl) * 128 + 8 * ch), a2 = *(const v4u*)(Oscr + (size_t)(1024 + pl) * 128 + 8 * ch);
        float o[8];
        o[0] = w0 * bflo(a0.x) + w1 * bflo(a1.x) + w2 * bflo(a2.x); o[1] = w0 * bfhi(a0.x) + w1 * bfhi(a1.x) + w2 * bfhi(a2.x);
        o[2] = w0 * bflo(a0.y) + w1 * bflo(a1.y) + w2 * bflo(a2.y); o[3] = w0 * bfhi(a0.y) + w1 * bfhi(a1.y) + w2 * bfhi(a2.y);
        o[4] = w0 * bflo(a0.z) + w1 * bflo(a1.z) + w2 * bflo(a2.z); o[5] = w0 * bfhi(a0.z) + w1 * bfhi(a1.z) + w2 * bfhi(a2.z);
        o[6] = w0 * bflo(a0.w) + w1 * bflo(a1.w) + w2 * bflo(a2.w); o[7] = w0 * bfhi(a0.w) + w1 * bfhi(a1.w) + w2 * bfhi(a2.w);
        float ss = 0.f;
#pragma unroll
        for (int i = 0; i < 8; ++i) ss += o[i] * o[i];
        ss += __shfl_xor(ss, 1); ss += __shfl_xor(ss, 2); ss += __shfl_xor(ss, 4); ss += __shfl_xor(ss, 8);
        v4u ow; ow.x = cvtpk(o[0], o[1]); ow.y = cvtpk(o[2], o[3]); ow.z = cvtpk(o[4], o[5]); ow.w = cvtpk(o[6], o[7]);
        *(v4u*)(MG + (size_t)(row0 + pl) * D + 1024 + h * 128 + 8 * ch) = ow;
        if (ch == 0) ssB[row0 + pl] = ss;
    }
    __syncthreads();
}

#define XB_TMO      128
#define XB_XCNT(j)  (256  + 64 * (j))
#define XB_XSUB(j)  (1280 + 64 * (j))
#define XB_XGEN(j)  (2304 + 64 * (j))
#define XB_TOP      3328
#define XB_TOPGEN   3392
#define XCD_BAR_WORDS 3456
#define XB_SPIN_CAP (1u << 18)

__device__ __forceinline__ unsigned xb_ld(unsigned* p)              { return __hip_atomic_load(p, __ATOMIC_RELAXED, __HIP_MEMORY_SCOPE_AGENT); }
__device__ __forceinline__ unsigned xb_add(unsigned* p, unsigned v) { return __hip_atomic_fetch_add(p, v, __ATOMIC_RELAXED, __HIP_MEMORY_SCOPE_AGENT); }
__device__ __forceinline__ unsigned xb_xcc_id() { return (unsigned)__builtin_amdgcn_s_getreg((3 << 11) | 20) & 0xFu; }
#define XB_SPIN(cond, bar) do { unsigned _sp = 0; while (cond) { __builtin_amdgcn_s_sleep(1); \
    if ((++_sp & 255u) == 0u) { if (xb_ld(&(bar)[XB_TMO])) break; if (_sp > XB_SPIN_CAP) { atomicAdd(&(bar)[XB_TMO], 1u); break; } } } } while (0)

struct XcdBarrier {
    unsigned* bar; unsigned x;
    volatile LAS unsigned* st;
};

__device__ __forceinline__ XcdBarrier xcd_barrier_post(unsigned* bar, volatile LAS unsigned* st, int wave_s) {
    XcdBarrier b; b.bar = bar; b.x = xb_xcc_id(); b.st = st;
    if (wave_s == 0 && fresh_lane() == 0) (void)xb_add(&bar[XB_XCNT(b.x)], 1u);
    return b;
}
__device__ __forceinline__ void xcd_barrier_complete(unsigned* bar, unsigned x, unsigned& nloc, unsigned& nx) {
    const unsigned G = gridDim.x * gridDim.y * gridDim.z;
    unsigned sum, cnt, mine, sp = 0u;
    for (;;) {
        sum = 0u; cnt = 0u; mine = 0u;
#pragma unroll
        for (unsigned j = 0; j < 16; ++j) { const unsigned c = xb_ld(&bar[XB_XCNT(j)]); sum += c; cnt += (c > 0u) ? 1u : 0u; mine = (j == x) ? c : mine; }
        if (sum == G) break;
        __builtin_amdgcn_s_sleep(1);
        if ((++sp & 255u) == 0u) { if (xb_ld(&bar[XB_TMO])) break; if (sp > XB_SPIN_CAP) { atomicAdd(&bar[XB_TMO], 1u); break; } }
    }
    nloc = mine > 0u ? mine : 1u; nx = cnt > 0u ? cnt : 1u;
}

__device__ __forceinline__ void xcd_barrier(const XcdBarrier& b, int wave_s) {
    asm volatile("s_waitcnt vmcnt(0)" ::: "memory");
    __syncthreads();
    if (wave_s == 0 && fresh_lane() == 0) {
        unsigned* bar = b.bar;
        __builtin_amdgcn_s_waitcnt(0);
        unsigned nloc = b.st[0], nx = b.st[1];
        if (nloc == 0u) { xcd_barrier_complete(bar, b.x, nloc, nx); b.st[0] = nloc; b.st[1] = nx; }
        const unsigned old = xb_add(&bar[XB_XSUB(b.x)], 1u);
        const unsigned gen = old / nloc;
        if (old + 1u == (gen + 1u) * nloc) {
            __builtin_amdgcn_fence(__ATOMIC_RELEASE, "agent");
            asm volatile("s_waitcnt vmcnt(0)" ::: "memory");
            const unsigned og = xb_add(&bar[XB_TOP], 1u);
            const unsigned tg = og / nx;
            if (og + 1u == (tg + 1u) * nx) xb_add(&bar[XB_TOPGEN], 1u);
            else XB_SPIN(xb_ld(&bar[XB_TOPGEN]) == tg, bar);
            __builtin_amdgcn_fence(__ATOMIC_ACQUIRE, "agent");
            xb_add(&bar[XB_XGEN(b.x)], 1u);
            asm volatile("s_waitcnt vmcnt(0)" ::: "memory");
        } else {
            XB_SPIN(xb_ld(&bar[XB_XGEN(b.x)]) == gen, bar);
            __builtin_amdgcn_fence(__ATOMIC_ACQUIRE, "agent");
            asm volatile("s_waitcnt vmcnt(0)" ::: "memory");
        }
    }
    __syncthreads();
}

__global__ void __launch_bounds__(NTHREADS, 2) fwd_megakernel(Args a) {
    extern __shared__ __attribute__((aligned(16))) unsigned char lds_raw[];
    LAS unsigned char* lds = (LAS unsigned char*)lds_raw;
    cg::grid_group grid = cg::this_grid();
#define PHASE_IDS() int tid = fresh_tid(wave_s); asm volatile("" : "+v"(tid)); const int lane = tid & 63, wave = __builtin_amdgcn_readfirstlane(tid >> 6); \
    int bid = blockIdx.x; asm volatile("" : "+s"(bid)); const int gw = bid * NWAVES + wave, NGW = G * NWAVES; (void)lane; (void)gw; (void)NGW;
    const int G = gridDim.x;
    const int wave_s = __builtin_amdgcn_readfirstlane(threadIdx.x >> 6);
    unsigned char* ws = a.ws;
    const float* rope = (const float*)(ws + WS_ROPE);
    {
        volatile LAS unsigned* misc0 = (volatile LAS unsigned*)(lds + MISC_OFF);
        if (threadIdx.x < 16) misc0[threadIdx.x] = 0u;
        if (blockIdx.x == 0) for (int i = threadIdx.x; i < 4096; i += NTHREADS) ((unsigned*)(ws + WS_CTL))[i] = 0u;
        __syncthreads();
    }

    for (int rep = 0; rep < REP_PRO; ++rep) { PHASE_IDS(); prologue_phase(a, lds, gw, NGW, wave, lane); }
    { PHASE_IDS(); resnorm_phase<true, false>(a, nullptr, a.in[2], gw, NGW, lane); }
    grid.sync();
    const XcdBarrier bar = xcd_barrier_post((unsigned*)(ws + WS_CTL), (volatile LAS unsigned*)(lds + MISC_OFF), wave_s);

#pragma unroll 1
    for (int l = 0; l < DEPTH; ++l) {
        {
            pg8::Gemm g{(const bf16*)(ws + WS_H), (const bf16*)(ws + WS_WIN) + (size_t)l * PW * D, T, PW, D};
            pg8::StaticOrder S; S.init(T, PW, G, (int)blockIdx.x);
            pg8::EpiProj E{(bf16*)(ws + WS_R1), rope, QSCALE};

            for (int rep = 0; rep < REP_GEMM; ++rep) { pg8::gemm_phase<pg8::EpiProj, pg8::StaticOrder, true, true>(lds, g, S, E, wave_s); }
            if (l + 1 < DEPTH) { PHASE_IDS(); (void)gw; convert_in_idle_slot(a, lds, l + 1, 0, (T / 256) * (PW / 256), G, bid, wave, lane); }
        }
        xcd_barrier(bar, wave_s);
        {
            constexpr int N_ATT = 8 * (T / 512), N_GM = 8 * (T / 128);
            PHASE_IDS(); (void)bid;
            unsigned* qhead = (unsigned*)(ws + WS_CTL) + 3584 + 64 * l;
            volatile LAS int* slot = (volatile LAS int*)(lds + MISC_OFF + 64);
            if (tid == 0) *slot = (int)__hip_atomic_fetch_add(qhead, 1u, __ATOMIC_RELAXED, __HIP_MEMORY_SCOPE_AGENT);
            __syncthreads();
            int it = *slot;
            while (it < N_ATT + N_GM) {
                __syncthreads();
                if (tid == 0) *slot = (int)__hip_atomic_fetch_add(qhead, 1u, __ATOMIC_RELAXED, __HIP_MEMORY_SCOPE_AGENT);
                if (it < N_ATT) attn_item(a, it & 7, it >> 3, lds, tid, wave, lane);
                else { const int j = it - N_ATT; gmlp_item(a, l, j >> 3, j & 7, lds, tid, wave, lane); }
                __syncthreads();
                it = *slot;
            }
        }
        xcd_barrier(bar, wave_s);
        {
            pg8::Gemm g{(const bf16*)(ws + WS_H), (const bf16*)(ws + WS_WO) + (size_t)l * D * D, T, D, D};
            pg8::StaticOrder S; S.init(T, D, G, (int)blockIdx.x);
            pg8::EpiMixKS E{(bf16*)(ws + WS_MIX), (float*)(ws + WS_SSM), (const float*)(ws + WS_SSA), (const float*)(ws + WS_SSB), (LAS float*)(lds + 131072), T};
            for (int rep = 0; rep < REP_GEMM; ++rep) { pg8::gemm_phase<pg8::EpiMixKS, pg8::StaticOrder, true, true>(lds, g, S, E, wave_s); }
        }
        xcd_barrier(bar, wave_s);
        { PHASE_IDS(); resnorm_phase<false, false>(a, a.in[10] + (size_t)l * D, a.in[11] + (size_t)l * D, gw, NGW, lane); }
        xcd_barrier(bar, wave_s);
        {
            pg8::Gemm g{(const bf16*)(ws + WS_H), (const bf16*)(ws + WS_WGU) + (size_t)l * 2 * FF * D, T, 2 * FF, D};
            pg8::StaticOrder S; S.init(T, 2 * FF, G, (int)blockIdx.x);
            pg8::EpiGU E{(bf16*)(ws + WS_R1)};

            for (int rep = 0; rep < REP_GEMM; ++rep) { pg8::gemm_phase<pg8::EpiGU, pg8::StaticOrder, true, true>(lds, g, S, E, wave_s); }
            if (l + 1 < DEPTH) { PHASE_IDS(); (void)gw; convert_in_idle_slot(a, lds, l + 1, 1, (T / 256) * (2 * FF / 256), G, bid, wave, lane); }
        }
        xcd_barrier(bar, wave_s);
        {
            pg8::Gemm g{(const bf16*)(ws + WS_R1), (const bf16*)(ws + WS_WDN) + (size_t)l * D * FF, T, D, FF};
            pg8::StaticOrder S; S.init(T, D, G, (int)blockIdx.x);
            pg8::EpiMix E{(bf16*)(ws + WS_MIX), (float*)(ws + WS_SSM)};

            for (int rep = 0; rep < REP_GEMM; ++rep) { pg8::gemm_phase<pg8::EpiMix, pg8::StaticOrder, true, true>(lds, g, S, E, wave_s); }
        }
        xcd_barrier(bar, wave_s);
        if (l + 1 < DEPTH) { { PHASE_IDS(); resnorm_phase<false, false>(a, a.in[15] + (size_t)l * D, a.in[2] + (size_t)(l + 1) * D, gw, NGW, lane); } xcd_barrier(bar, wave_s); }
        else { PHASE_IDS(); resnorm_phase<false, true>(a, a.in[15] + (size_t)l * D, nullptr, gw, NGW, lane); }
    }
}

extern "C" void kernel_launch(void* const* d_in, const int* in_sizes, int n_in, void* d_out, int out_size, void* d_ws, size_t ws_size, hipStream_t stream) {
    static int grid = 0;
    if (grid == 0) {
        if (n_in != 16 || out_size != T * D || ws_size < WS_END) { fprintf(stderr, "kernel_launch: unexpected shapes (n_in %d, out %d, ws %zu); nothing launched\n", n_in, out_size, ws_size); grid = -1; return; }
        int dev = 0, cus = 0, per_cu = 0;
        hipGetDevice(&dev); hipDeviceGetAttribute(&cus, hipDeviceAttributeMultiprocessorCount, dev);
        if (hipFuncSetAttribute((const void*)fwd_megakernel, hipFuncAttributeMaxDynamicSharedMemorySize, LDS_BYTES) != hipSuccess) { fprintf(stderr, "kernel_launch: hipFuncSetAttribute failed\n"); grid = -1; return; }
        if (hipOccupancyMaxActiveBlocksPerMultiprocessor(&per_cu, (const void*)fwd_megakernel, NTHREADS, LDS_BYTES) != hipSuccess || per_cu < 1) { fprintf(stderr, "kernel_launch: occupancy query says %d\n", per_cu); per_cu = 1; }
        (void)hipGetLastError();
        grid = cus * (per_cu > 1 ? 1 : per_cu);
        if (grid <= 0) grid = 256;
    }
    if (grid < 0) return;
    Args a{};
    for (int i = 0; i < 16; ++i) a.in[i] = (const float*)d_in[i];
    a.out = (float*)d_out; a.ws = (unsigned char*)d_ws;
    void* args[] = {&a};
    hipError_t e = hipLaunchCooperativeKernel((const void*)fwd_megakernel, dim3(grid), dim3(NTHREADS), args, LDS_BYTES, stream);
    if (e != hipSuccess) fprintf(stderr, "kernel_launch: cooperative launch failed: %s (grid %d)\n", hipGetErrorString(e), grid);
}
```

```cpp
#include <hip/hip_runtime.h>
#include <hip/hip_cooperative_groups.h>
#include <cstdio>
#include <cstdint>
namespace cg = cooperative_groups;
#ifndef REP_GEMM
#define REP_GEMM 1
#endif
#ifndef REP_MIX
#define REP_MIX 1
#endif
#ifndef REP_ATT
#define REP_ATT 1
#endif
#ifndef REP_PRO
#define REP_PRO 1
#endif
__device__ __forceinline__ int fresh_lane() { int l; asm volatile("v_mbcnt_lo_u32_b32 %0, -1, 0\n\tv_mbcnt_hi_u32_b32 %0, -1, %0" : "=v"(l)); return l; }
__device__ __forceinline__ int fresh_tid(int wave_s) { return wave_s * 64 + fresh_lane(); }
namespace pg8 {
#define PG8_LAS __attribute__((address_space(3)))
typedef unsigned short bf16_t;
typedef short bf16x8 __attribute__((ext_vector_type(8)));
typedef float f32x4 __attribute__((ext_vector_type(4)));
typedef unsigned u32x4 __attribute__((ext_vector_type(4)));
constexpr int BM = 256, BK = 64, HALF = 128, HTB = HALF * BK * 2  , STAGE_BYTES = 8 * HTB, NXCD = 8, WGM = 8;

__host__ __device__ __forceinline__ int lds_byte(int r, int c) { const int st = (r >> 4) * 2 + (c >> 5), rr = r & 15, cc = c & 31, ob = rr * 64 + cc * 2; return st * 1024 + (ob ^ (((ob >> 9) & 1) << 5)); }
__host__ __device__ __forceinline__ void stage_rc(int b, int& R, int& C) { const int st = b / 1024, sb = b % 1024, swz = sb ^ (((sb >> 9) & 1) << 5); R = (st >> 1) * 16 + swz / 64; C = (st & 1) * 32 + (swz % 64) / 2; }
__host__ __device__ __forceinline__ int perm32(int rho) { const int n = rho >> 4, i = rho & 15; return 8 * (i >> 2) + 4 * n + (i & 3); }

struct Unit { int pm, pn; };
struct Gemm { const bf16_t* A; const bf16_t* Bt; int M, N, K; };

struct StaticOrder {
    int nM, nN, nwg, G, c;
    __host__ __device__ void init(int M, int N, int G_, int c_) { nM = M / BM; nN = N / BM; nwg = nM * nN; G = G_; c = c_; }
    __host__ __device__ bool next(int i, Unit& u) const {
        const long L = (long)i * G + c; if (L >= nwg) return false;
        int wgid = (int)L; { const int q = nwg / NXCD, r = nwg % NXCD, xcd = wgid % NXCD, off = wgid / NXCD; wgid = (xcd < r ? xcd * (q + 1) : r * (q + 1) + (xcd - r) * q) + off; }
        const int nig = WGM * nN, gid = wgid / nig, fm = gid * WGM, gsz = (nM - fm) < WGM ? (nM - fm) : WGM;
        u.pm = fm + ((wgid % nig) % gsz); u.pn = (wgid % nig) / gsz; return true;
    }
    __device__ __forceinline__ void a_ready(const Unit&) const {}
    __device__ __forceinline__ void done(const Unit&) const {}
};
__device__ __forceinline__ unsigned cvt_pk_bf16(float lo, float hi) { unsigned r; asm volatile("v_cvt_pk_bf16_f32 %0, %1, %2" : "=v"(r) : "v"(lo), "v"(hi)); return r; }
typedef float f32x2 __attribute__((ext_vector_type(2)));
__device__ __forceinline__ float fast_sigmoid(float t) { return __builtin_amdgcn_rcpf(1.0f + __builtin_amdgcn_exp2f(-1.44269504089f * t)); }
__device__ __forceinline__ float gelu_tanh(float x) { const float t = 1.5957691216057308f * (x + 0.044715f * x * x * x); return x * fast_sigmoid(t); }
__device__ __forceinline__ float silu_f(float x) { return x * fast_sigmoid(x); }
typedef unsigned u32x2 __attribute__((ext_vector_type(2)));

struct EpiProj {
    static constexpr bool PERM = false, AFTER_DRAIN = false, KSPLIT = false;
    bf16_t* O; const float* rope; float qscale;
    __device__ __forceinline__ void operator()(const f32x4 (&acc)[2][2][4][2], const Unit& u, int wr, int wc, int fr, int fq) const {
        const int row0 = u.pm * BM + wr * 64 + fr, col0 = u.pn * BM + wc * 32 + 4 * fq;
        const int kind = u.pn >> 2;
        const bool do_rope = (kind == 2 || kind == 3) && (wc == 0);
#pragma unroll
        for (int ai = 0; ai < 2; ++ai)
#pragma unroll
            for (int m = 0; m < 4; ++m) {
                const int row = row0 + ai * HALF + m * 16;
                const int pos = row < 8192 ? row : row - 8192;
                bf16_t* rowp = O + (size_t)row * 5120 + col0;
                f32x4 cs = (f32x4){1.f, 1.f, 1.f, 1.f}, sn = (f32x4){0.f, 0.f, 0.f, 0.f};
                if (do_rope) { cs = *(const f32x4*)(rope + pos * 32 + 4 * fq); sn = *(const f32x4*)(rope + pos * 32 + 16 + 4 * fq); }
#pragma unroll
                for (int bj = 0; bj < 2; ++bj) {
                    f32x4 v0 = acc[ai][bj][m][0], v1 = acc[ai][bj][m][1];
                    if (kind < 2) {
#pragma unroll
                        for (int j = 0; j < 4; ++j) { v0[j] = gelu_tanh(v0[j]); v1[j] = gelu_tanh(v1[j]); }
                    } else if (do_rope) {
                        const f32x4 o0 = v0 * cs - v1 * sn, o1 = v1 * cs + v0 * sn; v0 = o0; v1 = o1;
                    }
                    if (kind == 2) { v0 = v0 * qscale; v1 = v1 * qscale; }
                    u32x2 w0, w1; w0.x = cvt_pk_bf16(v0[0], v0[1]); w0.y = cvt_pk_bf16(v0[2], v0[3]); w1.x = cvt_pk_bf16(v1[0], v1[1]); w1.y = cvt_pk_bf16(v1[2], v1[3]);
                    *(u32x2*)(rowp + bj * HALF) = w0; *(u32x2*)(rowp + bj * HALF + 16) = w1;
                }
            }
    }
};
struct EpiGU {
    static constexpr bool PERM = true, AFTER_DRAIN = false, KSPLIT = false;
    bf16_t* O;
    __device__ __forceinline__ void operator()(const f32x4 (&acc)[2][2][4][2], const Unit& u, int wr, int wc, int fr, int fq) const {
        const int row0 = u.pm * BM + wr * 64 + fr, col0 = u.pn * HALF + wc * 32 + 8 * fq;
#pragma unroll
        for (int ai = 0; ai < 2; ++ai)
#pragma unroll
            for (int m = 0; m < 4; ++m) {
                bf16_t* rowp = O + (size_t)(row0 + ai * HALF + m * 16) * 5632 + col0;
                f32x4 r0, r1;
#pragma unroll
                for (int j = 0; j < 4; ++j) { r0[j] = silu_f(acc[ai][0][m][0][j]) * acc[ai][1][m][0][j]; r1[j] = silu_f(acc[ai][0][m][1][j]) * acc[ai][1][m][1][j]; }
                u32x4 w; w.x = cvt_pk_bf16(r0[0], r0[1]); w.y = cvt_pk_bf16(r0[2], r0[3]); w.z = cvt_pk_bf16(r1[0], r1[1]); w.w = cvt_pk_bf16(r1[2], r1[3]);
                *(u32x4*)rowp = w;
            }
    }
};
struct EpiMix {
    static constexpr bool PERM = true, AFTER_DRAIN = false, KSPLIT = false;
    bf16_t* O; float* ss;
    __device__ __forceinline__ void operator()(const f32x4 (&acc)[2][2][4][2], const Unit& u, int wr, int wc, int fr, int fq) const {
        const int row0 = u.pm * BM + wr * 64 + fr, col0 = u.pn * BM + wc * 32 + 8 * fq;
#pragma unroll
        for (int ai = 0; ai < 2; ++ai)
#pragma unroll
            for (int m = 0; m < 4; ++m) {
                const int row = row0 + ai * HALF + m * 16;
                bf16_t* rowp = O + (size_t)row * 2048 + col0;
                float s = 0.f;
#pragma unroll
                for (int bj = 0; bj < 2; ++bj) {
                    const f32x4 v0 = acc[ai][bj][m][0], v1 = acc[ai][bj][m][1];
                    s += (v0[0] * v0[0] + v0[1] * v0[1]) + (v0[2] * v0[2] + v0[3] * v0[3]) + (v1[0] * v1[0] + v1[1] * v1[1]) + (v1[2] * v1[2] + v1[3] * v1[3]);
                    u32x4 w; w.x = cvt_pk_bf16(v0[0], v0[1]); w.y = cvt_pk_bf16(v0[2], v0[3]); w.z = cvt_pk_bf16(v1[0], v1[1]); w.w = cvt_pk_bf16(v1[2], v1[3]);
                    *(u32x4*)(rowp + bj * HALF) = w;
                }
                s += __shfl_xor(s, 16); s += __shfl_xor(s, 32);
                if (fq == 0) ss[(size_t)row * 32 + u.pn * 4 + wc] = s;
            }
    }
};

struct EpiMixKS {
    static constexpr bool PERM = true, AFTER_DRAIN = false, KSPLIT = true;
    bf16_t* O; float* ss; const float* ssA; const float* ssB; PG8_LAS float* tbl; int Trows;
    __device__ __forceinline__ void prep(const Unit& u, int ui, int tid) const {
        if (tid < 256) {
            const int row = u.pm * BM + tid; float sa = 0.f, sb = 0.f;
#pragma unroll
            for (int g = 0; g < 8; ++g) { sa += ssA[(size_t)g * Trows + row]; sb += ssB[(size_t)g * Trows + row]; }
            const float rA = 1.0f / sqrtf(sa * (1.0f / 1024.0f) + 1e-6f), rB = 1.0f / sqrtf(sb * (1.0f / 1024.0f) + 1e-6f);
            tbl[(ui & 1) * 512 + tid * 2 + 0] = rA / rB; tbl[(ui & 1) * 512 + tid * 2 + 1] = rB;
        }
    }
    __device__ __forceinline__ void mid(f32x4 (&acc)[2][2][4][2], int ui, int wr, int fr) const {
#pragma unroll
        for (int ai = 0; ai < 2; ++ai)
#pragma unroll
            for (int m = 0; m < 4; ++m) { const float sc = tbl[(ui & 1) * 512 + (ai * HALF + wr * 64 + m * 16 + fr) * 2];
#pragma unroll
                for (int bj = 0; bj < 2; ++bj)
#pragma unroll
                    for (int n = 0; n < 2; ++n) acc[ai][bj][m][n] = acc[ai][bj][m][n] * sc; }
    }
    __device__ __forceinline__ void epi_ks(const f32x4 (&acc)[2][2][4][2], const Unit& u, int ui, int wr, int wc, int fr, int fq) const {
        const int row0 = u.pm * BM + wr * 64 + fr, col0 = u.pn * BM + wc * 32 + 8 * fq;
#pragma unroll
        for (int ai = 0; ai < 2; ++ai)
#pragma unroll
            for (int m = 0; m < 4; ++m) {
                const int row = row0 + ai * HALF + m * 16;
                const float sc = tbl[(ui & 1) * 512 + (ai * HALF + wr * 64 + m * 16 + fr) * 2 + 1];
                bf16_t* rowp = O + (size_t)row * 2048 + col0;
                float s = 0.f;
#pragma unroll
                for (int bj = 0; bj < 2; ++bj) {
                    const f32x4 v0 = acc[ai][bj][m][0] * sc, v1 = acc[ai][bj][m][1] * sc;
                    s += (v0[0] * v0[0] + v0[1] * v0[1]) + (v0[2] * v0[2] + v0[3] * v0[3]) + (v1[0] * v1[0] + v1[1] * v1[1]) + (v1[2] * v1[2] + v1[3] * v1[3]);
                    u32x4 w; w.x = cvt_pk_bf16(v0[0], v0[1]); w.y = cvt_pk_bf16(v0[2], v0[3]); w.z = cvt_pk_bf16(v1[0], v1[1]); w.w = cvt_pk_bf16(v1[2], v1[3]);
                    *(u32x4*)(rowp + bj * HALF) = w;
                }
                s += __shfl_xor(s, 16); s += __shfl_xor(s, 32);
                if (fq == 0) ss[(size_t)row * 32 + u.pn * 4 + wc] = s;
            }
    }
    __device__ __forceinline__ void operator()(const f32x4 (&)[2][2][4][2], const Unit&, int, int, int, int) const {}
};

template <class Epi, class Sched, bool ALIGN_EPI = false, bool SP2 = false>
__device__ __forceinline__ void gemm_phase(PG8_LAS unsigned char* lds, const Gemm g, const Sched& S, const Epi& E, int wave_s) {
    int tid_ = fresh_tid(wave_s); asm volatile("" : "+v"(tid_));
    const int tid = tid_, wid = __builtin_amdgcn_readfirstlane(tid >> 6), lane = tid & 63, wr = wid >> 2, wc = wid & 3, fr = lane & 15, fq = lane >> 4;
    const int K = g.K, nt = K / BK;
    unsigned voffA[2], voffB[2];
#pragma unroll
    for (int i = 0; i < 2; ++i) { int R, C; stage_rc(tid * 16 + i * 8192, R, C); const int Rb = Epi::PERM ? ((R & ~31) + perm32(R & 31)) : R;
        voffA[i] = (unsigned)(R * K + C) * 2u; voffB[i] = (unsigned)(Rb * K + C) * 2u; }
    const size_t kstep = (size_t)(BK * 2);
    const size_t hstep = (size_t)HALF * K * 2;
    const size_t tstep = 2 * hstep;
    const unsigned ldsw = (unsigned)wid * 1024u;
    const int aoff = lds_byte(wr * 64 + fr, fq * 8), boff = lds_byte(wc * 32 + fr, fq * 8);
#define PG8_SA(b, h) (((b) * 2 + (h)) * HTB)
#define PG8_SB(b, h) ((4 + (b) * 2 + (h)) * HTB)
#define PG8_STAGE(bufoff, gbase, voff) do { _Pragma("unroll") for (int _i = 0; _i < 2; ++_i) \
        __builtin_amdgcn_global_load_lds((const unsigned*)((const char*)(gbase) + (voff)[_i]), (PG8_LAS unsigned*)(lds + (bufoff) + ldsw + _i * 8192), 16, 0, 0); } while (0)
#define PG8_LDA(dst, b, h) do { _Pragma("unroll") for (int m = 0; m < 4; ++m) _Pragma("unroll") for (int k = 0; k < 2; ++k) dst[m][k] = *(const PG8_LAS bf16x8*)(lds + PG8_SA(b, h) + aoff + m * 2048 + k * 1024); } while (0)
#define PG8_LDB(dst, b, h) do { _Pragma("unroll") for (int n = 0; n < 2; ++n) _Pragma("unroll") for (int k = 0; k < 2; ++k) dst[n][k] = *(const PG8_LAS bf16x8*)(lds + PG8_SB(b, h) + boff + n * 2048 + k * 1024); } while (0)
#define PG8_MMA(ai, bj, At, Bt) do { __builtin_amdgcn_s_setprio(1); _Pragma("unroll") for (int m = 0; m < 4; ++m) _Pragma("unroll") for (int n = 0; n < 2; ++n) _Pragma("unroll") for (int k = 0; k < 2; ++k) \
        acc[ai][bj][m][n] = __builtin_amdgcn_mfma_f32_16x16x32_bf16(Bt[n][k], At[m][k], acc[ai][bj][m][n], 0, 0, 0); __builtin_amdgcn_s_setprio(0); } while (0)
#define PG8_WAIT_V(n) asm volatile("s_waitcnt vmcnt(" #n ")" ::: "memory")
#define PG8_WAIT_L(n) asm volatile("s_waitcnt lgkmcnt(" #n ")" ::: "memory")
#define PG8_BAR __builtin_amdgcn_s_barrier()
#define PG8_SCHED __builtin_amdgcn_sched_barrier(0)
    Unit cur, nxt; int ui = 0;
    if (!S.next(0, cur)) return;
    if constexpr (Epi::KSPLIT) E.prep(cur, 0, tid);
    f32x4 acc[2][2][4][2];
#pragma unroll
    for (int a = 0; a < 2; ++a)
#pragma unroll
        for (int b = 0; b < 2; ++b)
#pragma unroll
            for (int m = 0; m < 4; ++m)
#pragma unroll
                for (int n = 0; n < 2; ++n) acc[a][b][m][n] = (f32x4){0.f, 0.f, 0.f, 0.f};
    bf16x8 At[4][2], B0[2][2], B1[2][2];
    const char* cA = (const char*)g.A + (size_t)cur.pm * tstep; const char* cB = (const char*)g.Bt + (size_t)cur.pn * tstep;
    S.a_ready(cur);
    if constexpr (SP2) {
        PG8_STAGE(PG8_SB(0, 0), cB, voffB); PG8_STAGE(PG8_SB(0, 1), cB + hstep, voffB); PG8_STAGE(PG8_SA(0, 0), cA, voffA); PG8_STAGE(PG8_SA(0, 1), cA + hstep, voffA);
        if (wr == 1) PG8_BAR;
        PG8_WAIT_V(2); PG8_BAR;
        PG8_STAGE(PG8_SB(1, 0), cB + kstep, voffB); PG8_STAGE(PG8_SA(1, 0), cA + kstep, voffA); PG8_STAGE(PG8_SB(1, 1), cB + hstep + kstep, voffB);
        PG8_WAIT_V(6); PG8_BAR;
    } else {
        PG8_STAGE(PG8_SB(0, 0), cB, voffB); PG8_STAGE(PG8_SA(0, 0), cA, voffA); PG8_STAGE(PG8_SB(0, 1), cB + hstep, voffB); PG8_STAGE(PG8_SA(0, 1), cA + hstep, voffA);
        if (wr == 1) PG8_BAR;
        PG8_WAIT_V(4); PG8_BAR;
        PG8_STAGE(PG8_SB(1, 0), cB + kstep, voffB); PG8_STAGE(PG8_SA(1, 0), cA + kstep, voffA); PG8_STAGE(PG8_SB(1, 1), cB + hstep + kstep, voffB);
        PG8_WAIT_V(6); PG8_BAR;
    }
    for (;;) {
        const bool has_next = S.next(ui + 1, nxt);
        const char* nA = has_next ? (const char*)g.A + (size_t)nxt.pm * tstep : cA; const char* nB = has_next ? (const char*)g.Bt + (size_t)nxt.pn * tstep : cB;
        for (int t = 0; t < nt; t += 2) {
            if constexpr (Epi::KSPLIT) { if (t == (nt >> 1)) E.mid(acc, ui, wr, fr); }
            const bool last = (t == nt - 2);
            const char* a1 = cA + (size_t)(t + 1) * kstep;
            const char* a2 = last ? nA : cA + (size_t)(t + 2) * kstep; const char* b2 = last ? nB : cB + (size_t)(t + 2) * kstep;
            const char* a3 = a2 + kstep; const char* b3 = b2 + kstep;
            if (last && has_next) S.a_ready(nxt);
            if constexpr (SP2) {
            PG8_LDB(B0, 0, 0); PG8_LDB(B1, 0, 1); PG8_SCHED; PG8_LDA(At, 0, 0); PG8_STAGE(PG8_SA(1, 1), a1 + hstep, voffA);
            PG8_WAIT_V(8); PG8_WAIT_L(0); PG8_BAR; PG8_MMA(0, 0, At, B0); PG8_MMA(0, 1, At, B1); PG8_BAR; PG8_SCHED;
            PG8_LDA(At, 0, 1); PG8_STAGE(PG8_SB(0, 0), b2, voffB); PG8_STAGE(PG8_SB(0, 1), b2 + hstep, voffB); PG8_STAGE(PG8_SA(0, 0), a2, voffA);
            PG8_WAIT_V(8); PG8_WAIT_L(0); PG8_BAR; PG8_MMA(1, 0, At, B0); PG8_MMA(1, 1, At, B1); PG8_BAR; PG8_SCHED;
            PG8_LDB(B0, 1, 0); PG8_LDB(B1, 1, 1); PG8_SCHED; PG8_LDA(At, 1, 0); PG8_STAGE(PG8_SA(0, 1), a2 + hstep, voffA);
            PG8_WAIT_V(8); PG8_WAIT_L(0); PG8_BAR; PG8_MMA(0, 0, At, B0); PG8_MMA(0, 1, At, B1); PG8_BAR; PG8_SCHED;
            PG8_LDA(At, 1, 1); PG8_STAGE(PG8_SB(1, 0), b3, voffB); PG8_STAGE(PG8_SB(1, 1), b3 + hstep, voffB); PG8_STAGE(PG8_SA(1, 0), a3, voffA);
            PG8_WAIT_V(8); PG8_WAIT_L(0); PG8_BAR; PG8_MMA(1, 0, At, B0); PG8_MMA(1, 1, At, B1); PG8_BAR; PG8_SCHED;
            } else {
            PG8_LDB(B0, 0, 0); PG8_SCHED; PG8_LDA(At, 0, 0); PG8_STAGE(PG8_SA(1, 1), a1 + hstep, voffA);
            PG8_WAIT_L(8); PG8_BAR; PG8_WAIT_L(0); PG8_MMA(0, 0, At, B0); PG8_BAR; PG8_SCHED;
            PG8_LDB(B1, 0, 1); PG8_STAGE(PG8_SB(0, 0), b2, voffB);
            PG8_BAR; PG8_WAIT_L(0); PG8_MMA(0, 1, At, B1); PG8_BAR;
            PG8_LDA(At, 0, 1); PG8_STAGE(PG8_SA(0, 0), a2, voffA);
            PG8_BAR; PG8_WAIT_L(0); PG8_MMA(1, 0, At, B0); PG8_BAR; PG8_SCHED;
            PG8_STAGE(PG8_SB(0, 1), b2 + hstep, voffB);
            PG8_WAIT_V(6); PG8_BAR; PG8_MMA(1, 1, At, B1); PG8_BAR;
            PG8_LDB(B0, 1, 0); PG8_SCHED; PG8_LDA(At, 1, 0); PG8_STAGE(PG8_SA(0, 1), a2 + hstep, voffA);
            PG8_WAIT_L(8); PG8_BAR; PG8_WAIT_L(0); PG8_MMA(0, 0, At, B0); PG8_BAR; PG8_SCHED;
            PG8_LDB(B1, 1, 1); PG8_STAGE(PG8_SB(1, 0), b3, voffB);
            PG8_BAR; PG8_WAIT_L(0); PG8_MMA(0, 1, At, B1); PG8_BAR;
            PG8_LDA(At, 1, 1); PG8_STAGE(PG8_SA(1, 0), a3, voffA);
            PG8_BAR; PG8_WAIT_L(0); PG8_MMA(1, 0, At, B0); PG8_BAR; PG8_SCHED;
            PG8_STAGE(PG8_SB(1, 1), b3 + hstep, voffB);
            PG8_WAIT_V(6); PG8_BAR; PG8_MMA(1, 1, At, B1); PG8_BAR;
            }
        }
        if constexpr (ALIGN_EPI) { if (wr == 0) PG8_BAR; }
        if constexpr (!Epi::AFTER_DRAIN) { if constexpr (Epi::KSPLIT) E.epi_ks(acc, cur, ui, wr, wc, fr, fq); else E(acc, cur, wr, wc, fr, fq); S.done(cur); }
        if (!has_next) break;
#pragma unroll
        for (int a = 0; a < 2; ++a)
#pragma unroll
            for (int b = 0; b < 2; ++b)
#pragma unroll
                for (int m = 0; m < 4; ++m)
#pragma unroll
                    for (int n = 0; n < 2; ++n) acc[a][b][m][n] = (f32x4){0.f, 0.f, 0.f, 0.f};
        cur = nxt; cA = nA; cB = nB; ++ui;
        if constexpr (Epi::KSPLIT) E.prep(cur, ui, tid);
        if constexpr (ALIGN_EPI) { if (wr == 1) PG8_BAR; }
    }
    PG8_WAIT_V(0);
    if constexpr (!ALIGN_EPI) { if (wr == 0) PG8_BAR; }
    PG8_BAR;
    if constexpr (Epi::AFTER_DRAIN) { E.fused(acc, cur, wr, wc, fr, fq, lds, wid, lane); S.done(cur); }
#undef PG8_SA
#undef PG8_SB
#undef PG8_STAGE
#undef PG8_LDA
#undef PG8_LDB
#undef PG8_MMA
#undef PG8_WAIT_V
#undef PG8_WAIT_L
#undef PG8_BAR
#undef PG8_SCHED
}
}
#define LAS __attribute__((address_space(3)))
typedef unsigned short bf16;
typedef float f32x4 __attribute__((ext_vector_type(4)));
typedef float f32x16 __attribute__((ext_vector_type(16)));
typedef short bf16x8 __attribute__((ext_vector_type(8)));
typedef short s16x4 __attribute__((ext_vector_type(4)));
typedef unsigned v4u __attribute__((ext_vector_type(4)));
typedef unsigned v2u __attribute__((ext_vector_type(2)));

constexpr int NWAVES = 8, NTHREADS = 512;
constexpr int T_P = 8192, T_S = 16384, T = T_P + T_S, D = 2048, PW = 5120, FF = 5632, DEPTH = 4;
constexpr int C_U = 0, C_VA = 1024, C_Q = 2048, C_K = 3072, C_V = 4096;
constexpr float EPS = 1e-6f;
constexpr float QSCALE = 0.08838834764831845f * 1.4426950408889634f;

constexpr size_t MiB = 1u << 20;
constexpr size_t WS_CTL = 0;
constexpr size_t WS_ROPE = 1 * MiB;
constexpr size_t WS_WSB = 3 * MiB;
constexpr size_t WS_SSA = 4 * MiB;
constexpr size_t WS_SSB = 5 * MiB;
constexpr size_t WS_SSM = 6 * MiB;
constexpr size_t WS_LSE = 9 * MiB;
constexpr size_t WS_WIN = 12 * MiB;
constexpr size_t WS_WO = 92 * MiB;
constexpr size_t WS_WGU = 124 * MiB;
constexpr size_t WS_WDN = 300 * MiB;
constexpr size_t WS_H = 388 * MiB;
constexpr size_t WS_R1 = 484 * MiB;
constexpr size_t WS_MIX = 748 * MiB;
constexpr size_t WS_X = 844 * MiB;
constexpr size_t WS_END = 940 * MiB;
constexpr int LDS_BYTES = 147456, MISC_OFF = 131072 + 12288;

__device__ __forceinline__ unsigned cvtpk(float lo, float hi) { unsigned r; asm volatile("v_cvt_pk_bf16_f32 %0, %1, %2" : "=v"(r) : "v"(lo), "v"(hi)); return r; }
__device__ __forceinline__ float bflo(unsigned w) { return __uint_as_float(w << 16); }
__device__ __forceinline__ float bfhi(unsigned w) { return __uint_as_float(w & 0xffff0000u); }
__device__ __forceinline__ float wave_sum(float v) {
#pragma unroll
    for (int o = 1; o < 64; o <<= 1) v += __shfl_xor(v, o);
    return v;
}

struct Args { const float* in[16]; float* out; unsigned char* ws; };

__device__ __forceinline__ void transpose_item(const float* W, int K, int N, bf16* WT, int mode, LAS float* scr, int item, int lane, const float* kscale = nullptr) {
    const int nblk = N / 32, kb = item / nblk, nb = item % nblk, k0 = 64 * kb, n0 = 32 * nb;
    const int drow0 = mode == 0 ? n0 : (256 * (n0 >> 7) + (n0 & 127) + (mode == 2 ? 128 : 0));
#pragma unroll 8
    for (int i = 0; i < 32; ++i) { const int kk = 2 * i + (lane >> 5); float w = W[(size_t)(k0 + kk) * N + n0 + (lane & 31)]; if (kscale) w *= kscale[k0 + kk]; scr[kk * 33 + (lane & 31)] = w; }
    asm volatile("s_waitcnt lgkmcnt(0)" ::: "memory");
    const int c = lane & 7;
#pragma unroll
    for (int j = 0; j < 4; ++j) { const int n = (lane >> 3) + 8 * j; const LAS float* s = scr + (8 * c) * 33 + n;
        v4u o; o.x = cvtpk(s[0 * 33], s[1 * 33]); o.y = cvtpk(s[2 * 33], s[3 * 33]); o.z = cvtpk(s[4 * 33], s[5 * 33]); o.w = cvtpk(s[6 * 33], s[7 * 33]);
        *(v4u*)(WT + (size_t)(drow0 + n) * K + k0 + 8 * c) = o; }
    asm volatile("s_waitcnt lgkmcnt(0)" ::: "memory");
}

constexpr int CV_IN = (D / 64) * (PW / 32), CV_O = (D / 64) * (D / 32), CV_G = (D / 64) * (FF / 32), CV_D = (FF / 64) * (D / 32);
constexpr int CV_PER_L = CV_IN + CV_O + 2 * CV_G + CV_D;
constexpr int CV_WSTRIDE = 2 * 64 * 33 * 4;
struct CvDesc { const float* W; bf16* WT; const float* ks; int K, N, k0, n0, drow0; };
__device__ __forceinline__ CvDesc cv_desc(const Args& a, int l, int r) {
    unsigned char* ws = a.ws; CvDesc d; int mode = 0; d.ks = nullptr;
    if (r < CV_IN) { d.W = a.in[3] + (size_t)l * D * PW; d.K = D; d.N = PW; d.WT = (bf16*)(ws + WS_WIN) + (size_t)l * PW * D; }
    else if ((r -= CV_IN) < CV_O) { d.W = a.in[9] + (size_t)l * D * D; d.K = D; d.N = D; d.WT = (bf16*)(ws + WS_WO) + (size_t)l * D * D;
        const int kb_ = r / (D / 32); d.ks = (kb_ < 16 ? a.in[7] + (size_t)l * 1024 : a.in[8] + (size_t)l * 1024 - 1024); }
    else if ((r -= CV_O) < CV_G) { d.W = a.in[12] + (size_t)l * D * FF; d.K = D; d.N = FF; d.WT = (bf16*)(ws + WS_WGU) + (size_t)l * 2 * FF * D; mode = 1; }
    else if ((r -= CV_G) < CV_G) { d.W = a.in[13] + (size_t)l * D * FF; d.K = D; d.N = FF; d.WT = (bf16*)(ws + WS_WGU) + (size_t)l * 2 * FF * D; mode = 2; }
    else { r -= CV_G; d.W = a.in[14] + (size_t)l * FF * D; d.K = FF; d.N = D; d.WT = (bf16*)(ws + WS_WDN) + (size_t)l * D * FF; }
    const int nblk = d.N / 32, kb = r / nblk, nb = r % nblk; d.k0 = 64 * kb; d.n0 = 32 * nb;
    d.drow0 = mode == 0 ? d.n0 : (256 * (d.n0 >> 7) + (d.n0 & 127) + (mode == 2 ? 128 : 0));
    return d;
}
__device__ __forceinline__ void cv_load(const CvDesc& d, float (&r)[32], int lane) {
#pragma unroll
    for (int i = 0; i < 32; ++i) { const int kk = 2 * i + (lane >> 5); r[i] = __builtin_nontemporal_load(d.W + (size_t)(d.k0 + kk) * d.N + d.n0 + (lane & 31)); }
}
__device__ __forceinline__ void cv_lds(const CvDesc& d, const float (&r)[32], LAS float* scr, int lane) {
#pragma unroll
    for (int i = 0; i < 32; ++i) { const int kk = 2 * i + (lane >> 5); float w = r[i]; if (d.ks) w *= d.ks[d.k0 + kk]; scr[kk * 33 + (lane & 31)] = w; }
}
__device__ __forceinline__ void cv_store(const CvDesc& d, const LAS float* scr, int lane) {
    const int c = lane & 7;
#pragma unroll
    for (int j = 0; j < 4; ++j) { const int n = (lane >> 3) + 8 * j; const LAS float* s = scr + (8 * c) * 33 + n;
        v4u o; o.x = cvtpk(s[0 * 33], s[1 * 33]); o.y = cvtpk(s[2 * 33], s[3 * 33]); o.z = cvtpk(s[4 * 33], s[5 * 33]); o.w = cvtpk(s[6 * 33], s[7 * 33]);
        *(v4u*)(d.WT + (size_t)(d.drow0 + n) * d.K + d.k0 + 8 * c) = o; }
}
__device__ __forceinline__ void convert_items(const Args& a, LAS unsigned char* lds, int l, int lo, int hi, int gwx, int NW, int wave, int lane) {
    LAS float* scr0 = (LAS float*)(lds + wave * CV_WSTRIDE); LAS float* scr1 = scr0 + 64 * 33;
    for (int it = lo + gwx; it < hi; it += 2 * NW) {
        const bool two = it + NW < hi;
        const CvDesc d0 = cv_desc(a, l, it), d1 = cv_desc(a, l, two ? it + NW : it);
        float r0[32], r1[32];
        cv_load(d0, r0, lane); if (two) cv_load(d1, r1, lane);
        cv_lds(d0, r0, scr0, lane); if (two) cv_lds(d1, r1, scr1, lane);
        asm volatile("s_waitcnt lgkmcnt(0)" ::: "memory");
        cv_store(d0, scr0, lane); if (two) cv_store(d1, scr1, lane);
        asm volatile("s_waitcnt lgkmcnt(0)" ::: "memory");
    }
}
__device__ __forceinline__ void convert_in_idle_slot(const Args& a, LAS unsigned char* lds, int l_next, int part, int nwg, int G, int bid, int wave, int lane) {
    const int first_idle = nwg % G;
    const int nidle = first_idle ? G - first_idle : G;
    if (first_idle && bid < first_idle) return;
    const int half = CV_PER_L / 2;
    convert_items(a, lds, l_next, part ? half : 0, part ? CV_PER_L : half, (bid - first_idle) * NWAVES + wave, nidle * NWAVES, wave, lane);
}
__device__ __forceinline__ void prologue_phase(const Args& a, LAS unsigned char* lds, int gw, int NGW, int wave, int lane) {
    unsigned char* ws = a.ws;
    convert_items(a, lds, 0, 0, CV_PER_L, gw, NGW, wave, lane);
    { const float* src = a.in[5]; bf16* dst = (bf16*)(ws + WS_WSB); const int n4 = DEPTH * 8 * 128 * 128 / 4;
      for (int i = gw * 64 + lane; i < n4; i += NGW * 64) { const f32x4 v = ((const f32x4*)src)[i]; v2u o; o.x = cvtpk(v[0], v[1]); o.y = cvtpk(v[2], v[3]); ((v2u*)dst)[i] = o; } }
    { float* tab = (float*)(ws + WS_ROPE);
      for (int i = gw * 64 + lane; i < 16384 * 16; i += NGW * 64) { const int pos = i >> 4, f = i & 15;
          const float inv = (float)pow(500000.0, -(double)f / 16.0); const float ang = (float)pos * inv;
          tab[pos * 32 + f] = (float)cos((double)ang); tab[pos * 32 + 16 + f] = (float)sin((double)ang); } }
}

template <bool FIRST, bool LAST>
__device__ __forceinline__ void resnorm_phase(const Args& a, const float* g_post, const float* g_next, int gw, int NGW, int lane) {
    unsigned char* ws = a.ws; bf16* X = (bf16*)(ws + WS_X); bf16* H = (bf16*)(ws + WS_H);
    const bf16* MIXb = (const bf16*)(ws + WS_MIX); const float* ssM = (const float*)(ws + WS_SSM);
    constexpr int R = FIRST ? 2 : 4;
    f32x4 gp[8], gn[8];
#pragma unroll
    for (int j = 0; j < 8; ++j) { gp[j] = FIRST ? (f32x4){0.f, 0.f, 0.f, 0.f} : ((const f32x4*)g_post)[lane + 64 * j]; gn[j] = LAST ? (f32x4){0.f, 0.f, 0.f, 0.f} : ((const f32x4*)g_next)[lane + 64 * j]; }
    for (int row0 = gw; row0 < T; row0 += R * NGW) {
        v2u xv[R][8], m[R][8]; f32x4 vin[FIRST ? R : 1][8]; float ssp[R];
#pragma unroll
        for (int q = 0; q < R; ++q) { const int row = row0 + q * NGW; if (row < T) {
            if (FIRST) {
                const f32x4* src = (const f32x4*)(row < T_P ? a.in[0] + (size_t)row * D : a.in[1] + (size_t)(row - T_P) * D);
#pragma unroll
                for (int j = 0; j < 8; ++j) vin[FIRST ? q : 0][j] = __builtin_nontemporal_load(src + lane + 64 * j);
            } else {
                const v2u* xr = (const v2u*)(X + (size_t)row * D); const v2u* mp = (const v2u*)(MIXb + (size_t)row * D);
#pragma unroll
                for (int j = 0; j < 8; ++j) { xv[q][j] = __builtin_nontemporal_load(xr + lane + 64 * j); m[q][j] = __builtin_nontemporal_load(mp + lane + 64 * j); }
                ssp[q] = lane < 32 ? ssM[(size_t)row * 32 + lane] : 0.f;
            } } }
#pragma unroll
        for (int q = 0; q < R; ++q) { const int row = row0 + q * NGW; if (row < T) {
            f32x4 v[8];
            if (FIRST) {
#pragma unroll
                for (int j = 0; j < 8; ++j) v[j] = vin[FIRST ? q : 0][j];
            } else {
                const float rinv = 1.0f / sqrtf(wave_sum(ssp[q]) * (1.0f / D) + EPS);
#pragma unroll
                for (int j = 0; j < 8; ++j) {
                    v[j][0] = bflo(xv[q][j].x) + bflo(m[q][j].x) * rinv * gp[j][0]; v[j][1] = bfhi(xv[q][j].x) + bfhi(m[q][j].x) * rinv * gp[j][1];
                    v[j][2] = bflo(xv[q][j].y) + bflo(m[q][j].y) * rinv * gp[j][2]; v[j][3] = bfhi(xv[q][j].y) + bfhi(m[q][j].y) * rinv * gp[j][3]; }
            }
            if (LAST) {
                f32x4* yo = (f32x4*)(a.out + (size_t)row * D);
#pragma unroll
                for (int j = 0; j < 8; ++j) yo[lane + 64 * j] = v[j];
            } else {
                v2u* xo = (v2u*)(X + (size_t)row * D); v2u* ho = (v2u*)(H + (size_t)row * D); float s2 = 0.f;
#pragma unroll
                for (int j = 0; j < 8; ++j) { v2u o; o.x = cvtpk(v[j][0], v[j][1]); o.y = cvtpk(v[j][2], v[j][3]); xo[lane + 64 * j] = o;
                    s2 += (v[j][0] * v[j][0] + v[j][1] * v[j][1]) + (v[j][2] * v[j][2] + v[j][3] * v[j][3]); }
                const float r2 = 1.0f / sqrtf(wave_sum(s2) * (1.0f / D) + EPS);
#pragma unroll
                for (int j = 0; j < 8; ++j) { v2u o; o.x = cvtpk(v[j][0] * r2 * gn[j][0], v[j][1] * r2 * gn[j][1]); o.y = cvtpk(v[j][2] * r2 * gn[j][2], v[j][3] * r2 * gn[j][3]); ho[lane + 64 * j] = o; }
            } } }
    }
}

__device__ __forceinline__ void mnorm_phase(const Args& a, const float* gA, const float* gB, int gw, int NGW, int lane) {
    unsigned char* ws = a.ws; bf16* MG = (bf16*)(ws + WS_H); const float* ssA = (const float*)(ws + WS_SSA); const float* ssB = (const float*)(ws + WS_SSB);
    for (int row = gw; row < T; row += NGW) {
        float p = lane < 8 ? ssA[(size_t)lane * T + row] : (lane < 16 ? ssB[(size_t)(lane - 8) * T + row] : 0.f);
        p += __shfl_xor(p, 1); p += __shfl_xor(p, 2); p += __shfl_xor(p, 4);
        const float sa = __shfl(p, 0), sb = __shfl(p, 8);
        const float rA = 1.0f / sqrtf(sa * (1.0f / 1024.0f) + EPS), rB = 1.0f / sqrtf(sb * (1.0f / 1024.0f) + EPS);
        v4u* rp = (v4u*)(MG + (size_t)row * D);
#pragma unroll
        for (int j = 0; j < 4; ++j) {
            const int ch = lane + 64 * j; v4u w = rp[ch];
            const float r = j < 2 ? rA : rB; const float* g = (j < 2 ? gA : gB) + (ch & 127) * 8;
            const f32x4 g0 = *(const f32x4*)g, g1 = *(const f32x4*)(g + 4);
            v4u o; o.x = cvtpk(bflo(w.x) * r * g0[0], bfhi(w.x) * r * g0[1]); o.y = cvtpk(bflo(w.y) * r * g0[2], bfhi(w.y) * r * g0[3]);
            o.z = cvtpk(bflo(w.z) * r * g1[0], bfhi(w.z) * r * g1[1]); o.w = cvtpk(bflo(w.w) * r * g1[2], bfhi(w.w) * r * g1[3]);
            rp[ch] = o;
        }
    }
}

constexpr int GM_LDT = 136;
__device__ __forceinline__ void gmlp_item(const Args& a, int layer, int chunk, int g, LAS unsigned char* lds, int tid_in, int wave, int lane_in) {
    int tid = tid_in; asm volatile("" : "+v"(tid)); const int lane = tid & 63; (void)lane_in;
    unsigned char* ws = a.ws; const bf16* PROJ = (const bf16*)(ws + WS_R1); bf16* MG = (bf16*)(ws + WS_H);
    LAS bf16* Vt = (LAS bf16*)lds;
    LAS float* ssl = (LAS float*)(lds + (128 * GM_LDT + 64) * 2);
    const int R0 = chunk * 128;
    const int tq = wave & 3, chh = wave >> 2, hf = lane >> 5, l31 = lane & 31;
    const int t = 32 * tq + l31, row = R0 + t;
    bf16x8 bfr[8]; v2u uw[2][4];
    { const bf16* wsb = (const bf16*)(ws + WS_WSB) + ((size_t)(layer * 8 + g) * 128 + t) * 128 + 8 * hf;
#pragma unroll
      for (int ks = 0; ks < 8; ++ks) bfr[ks] = *(const bf16x8*)(wsb + 16 * ks);
      const bf16* up = PROJ + (size_t)row * PW + C_U + g * 128 + 64 * chh + 4 * hf;
#pragma unroll
      for (int cb = 0; cb < 2; ++cb)
#pragma unroll
          for (int g4 = 0; g4 < 4; ++g4) uw[cb][g4] = *(const v2u*)(up + 32 * cb + 8 * g4); }
    const float bias = a.in[6][(size_t)layer * 1024 + g * 128 + t];
    {
        const int s = tid >> 2, q = tid & 3;
        const v4u* vp = (const v4u*)(PROJ + (size_t)(R0 + s) * PW + C_VA + g * 128 + 32 * q);
        float x[32];
#pragma unroll
        for (int i = 0; i < 4; ++i) { const v4u w = vp[i]; x[8 * i + 0] = bflo(w.x); x[8 * i + 1] = bfhi(w.x); x[8 * i + 2] = bflo(w.y); x[8 * i + 3] = bfhi(w.y);
            x[8 * i + 4] = bflo(w.z); x[8 * i + 5] = bfhi(w.z); x[8 * i + 6] = bflo(w.w); x[8 * i + 7] = bfhi(w.w); }
        float sm = 0.f;
#pragma unroll
        for (int i = 0; i < 32; ++i) sm += x[i];
        sm += __shfl_xor(sm, 1); sm += __shfl_xor(sm, 2);
        const float mu = sm * (1.0f / 128.0f); float vq = 0.f;
#pragma unroll
        for (int i = 0; i < 32; ++i) { x[i] -= mu; vq += x[i] * x[i]; }
        vq += __shfl_xor(vq, 1); vq += __shfl_xor(vq, 2);
        const float rs = 1.0f / sqrtf(vq * (1.0f / 128.0f) + EPS);
        const f32x4* gn4 = (const f32x4*)(a.in[4] + (size_t)layer * 1024 + g * 128 + 32 * q);
        float gn[32];
#pragma unroll
        for (int i = 0; i < 8; ++i) { const f32x4 gv = gn4[i]; gn[4 * i] = gv[0]; gn[4 * i + 1] = gv[1]; gn[4 * i + 2] = gv[2]; gn[4 * i + 3] = gv[3]; }
#pragma unroll
        for (int i = 0; i < 32; i += 2) { const unsigned w = cvtpk(x[i] * rs * gn[i], x[i + 1] * rs * gn[i + 1]);
            Vt[(32 * q + i) * GM_LDT + 16 * q + s] = (bf16)(w & 0xffffu); Vt[(32 * q + i + 1) * GM_LDT + 16 * q + s] = (bf16)(w >> 16); }
    }
    __syncthreads();
    {
        f32x16 acc0, acc1;
#pragma unroll
        for (int i = 0; i < 16; ++i) { acc0[i] = 0.f; acc1[i] = 0.f; }
#pragma unroll
        for (int ks = 0; ks < 8; ++ks) {
            const bf16x8 a0 = *(const LAS bf16x8*)(Vt + (64 * chh + l31) * GM_LDT + 16 * (2 * chh) + 16 * ks + 8 * hf);
            const bf16x8 a1 = *(const LAS bf16x8*)(Vt + (64 * chh + 32 + l31) * GM_LDT + 16 * (2 * chh + 1) + 16 * ks + 8 * hf);
            acc0 = __builtin_amdgcn_mfma_f32_32x32x16_bf16(a0, bfr[ks], acc0, 0, 0, 0);
            acc1 = __builtin_amdgcn_mfma_f32_32x32x16_bf16(a1, bfr[ks], acc1, 0, 0, 0);
        }
        bf16* op = MG + (size_t)row * D + g * 128 + 64 * chh + 4 * hf;
        float ss = 0.f;
#pragma unroll
        for (int cb = 0; cb < 2; ++cb)
#pragma unroll
            for (int g4 = 0; g4 < 4; ++g4) {
                const v2u uwv = uw[cb][g4];
                float o0, o1, o2, o3;
                if (cb == 0) { o0 = bflo(uwv.x) * (acc0[4 * g4 + 0] + bias); o1 = bfhi(uwv.x) * (acc0[4 * g4 + 1] + bias); o2 = bflo(uwv.y) * (acc0[4 * g4 + 2] + bias); o3 = bfhi(uwv.y) * (acc0[4 * g4 + 3] + bias); }
                else         { o0 = bflo(uwv.x) * (acc1[4 * g4 + 0] + bias); o1 = bfhi(uwv.x) * (acc1[4 * g4 + 1] + bias); o2 = bflo(uwv.y) * (acc1[4 * g4 + 2] + bias); o3 = bfhi(uwv.y) * (acc1[4 * g4 + 3] + bias); }
                ss += (o0 * o0 + o1 * o1) + (o2 * o2 + o3 * o3);
                v2u ow; ow.x = cvtpk(o0, o1); ow.y = cvtpk(o2, o3);
                *(v2u*)(op + 32 * cb + 8 * g4) = ow;
            }
        ss += __shfl_xor(ss, 32);
        if (hf == 0) ssl[chh * 128 + t] = ss;
    }
    __syncthreads();
    if (tid < 128) ((float*)(ws + WS_SSA))[(size_t)g * T + R0 + tid] = ssl[tid] + ssl[128 + tid];
}

__device__ __forceinline__ unsigned voff_b(unsigned row, unsigned ch) { return 256u * row + 16u * (ch ^ (((row & 3) << 2) | ((row >> 2) & 3))); }
typedef short v4i16_t __attribute__((ext_vector_type(4)));
__device__ __forceinline__ s16x4 vtr(const LAS unsigned char* p) { return __builtin_bit_cast(s16x4, __builtin_amdgcn_ds_read_tr16_b64_v4i16((LAS v4i16_t*)p)); }

__device__ __forceinline__ void glds16(const void* gsrc, unsigned lds_dst) { unsigned keep;
    asm volatile("s_mov_b32 %0, m0\n\ts_mov_b32 m0, %2\n\ts_nop 0\n\tglobal_load_lds_dwordx4 %1, off\n\ts_mov_b32 m0, %0" : "=&s"(keep) : "v"(gsrc), "s"(lds_dst) : "memory"); }
__device__ __forceinline__ void glds16s(const void* sbase, unsigned voff, unsigned lds_dst) { unsigned keep;
    asm volatile("s_mov_b32 %0, m0\n\ts_mov_b32 m0, %3\n\ts_nop 0\n\tglobal_load_lds_dwordx4 %1, %2\n\ts_mov_b32 m0, %0" : "=&s"(keep) : "v"(voff), "s"(sbase), "s"(lds_dst) : "memory"); }
#define ATT_DMA_FAST(FIRST, COLBASE, BUF) do { \
        const bf16* sb_ = PROJ + (size_t)(seq_base + r + dd * (FIRST)) * PW + (COLBASE) + h * 128; \
        const unsigned l0_ = (unsigned)__builtin_amdgcn_readfirstlane((int)(unsigned)(uintptr_t)(BUF)); \
        _Pragma("unroll") for (int i_ = 0; i_ < 8; ++i_) glds16s(sb_ + (size_t)i_ * 4 * dd * PW, voffs[i_ & 3], l0_ + 1024u * i_); \
    } while (0)
#define ATT_DMA_ANY(FIRST, COLBASE, BUF) do { if (edge) ATT_DMA(FIRST, COLBASE, BUF); else ATT_DMA_FAST(FIRST, COLBASE, BUF); } while (0)
#define ATT_DMA(FIRST, COLBASE, BUF) do { \
        int f0_ = (FIRST); asm volatile("" : "+s"(f0_)); \
        _Pragma("unroll") for (int i_ = 0; i_ < 8; ++i_) { const int row_ = 4 * i_ + (lane >> 4); int kj_ = f0_ + row_; kj_ = kj_ < 0 ? 0 : (kj_ >= L ? L - 1 : kj_); \
            const int ch_ = (lane & 15) ^ (((row_ & 3) << 2) | ((row_ >> 2) & 3)); \
            glds16(PROJ + (size_t)(seq_base + r + dd * kj_) * PW + (COLBASE) + h * 128 + 8 * ch_, (unsigned)__builtin_amdgcn_readfirstlane((int)(unsigned)(uintptr_t)((BUF) + 1024 * i_))); } \
    } while (0)
#define ATT_ROWFRAGS(DST, BUF) do { _Pragma("unroll") for (int s_ = 0; s_ < 8; ++s_) DST[s_] = *(const LAS bf16x8*)((BUF) + voff_b(l31, 2 * s_ + hf)); } while (0)
#define ATT_SOFTMAX_PV(KB, VBUF, WAITV) do { \
        if ((KB) == 0) { _Pragma("unroll") for (int i = 0; i < 16; ++i) { if ((i & 3) + 8 * (i >> 2) < lm) S[i] = -1e30f; } }            \
        else if ((KB) == 4) { _Pragma("unroll") for (int i = 0; i < 16; ++i) { if ((i & 3) + 8 * (i >> 2) > lm) S[i] = -1e30f; } }     \
        if (edge) { _Pragma("unroll") for (int i = 0; i < 16; ++i) { const int kj = J0 - 64 + 32 * (KB) + 4 * hf + (i & 3) + 8 * (i >> 2); if (kj < 0 || kj >= L) S[i] = -1e30f; } } \
        float bm = S[0]; \
        _Pragma("unroll") for (int i = 1; i < 16; ++i) bm = fmaxf(bm, S[i]); \
        bm = fmaxf(bm, __shfl_xor(bm, 32)); \
        const float mnew = fmaxf(mrun, bm); \
        const float alpha = __builtin_amdgcn_exp2f(mrun - mnew); \
        mrun = mnew; \
        float ps = 0.f; \
        _Pragma("unroll") for (int i = 0; i < 16; ++i) { S[i] = __builtin_amdgcn_exp2f(S[i] - mnew); ps += S[i]; } \
        lsum = lsum * alpha + ps; \
        _Pragma("unroll") for (int db = 0; db < 4; ++db) _Pragma("unroll") for (int i = 0; i < 16; ++i) O[db][i] *= alpha; \
        bf16x8 pf[2]; \
        _Pragma("unroll") for (int j = 0; j < 2; ++j) { v4u w; w.x = cvtpk(S[8 * j + 0], S[8 * j + 1]); w.y = cvtpk(S[8 * j + 2], S[8 * j + 3]); w.z = cvtpk(S[8 * j + 4], S[8 * j + 5]); w.w = cvtpk(S[8 * j + 6], S[8 * j + 7]); \
            pf[j] = __builtin_bit_cast(bf16x8, w); } \
        WAITV; \
        _Pragma("unroll") for (int db = 0; db < 4; ++db) _Pragma("unroll") for (int j = 0; j < 2; ++j) { \
                const s16x4 lo = vtr((VBUF) + tb[0][db] + 4096 * j); \
                const s16x4 hi = vtr((VBUF) + tb[1][db] + 4096 * j); \
                bf16x8 vf; vf[0] = lo[0]; vf[1] = lo[1]; vf[2] = lo[2]; vf[3] = lo[3]; vf[4] = hi[0]; vf[5] = hi[1]; vf[6] = hi[2]; vf[7] = hi[3]; \
                O[db] = __builtin_amdgcn_mfma_f32_32x32x16_bf16(vf, pf[j], O[db], 0, 0, 0); } \
    } while (0)
__device__ __forceinline__ void attn_wave_tile(const bf16* PROJ, int seq_base, int L, int dd, int r, int J0, int h, LAS unsigned char* vl, bf16* Oscr, float* lse_scr, int P0, int lane, int rot) {
    const int hf = lane >> 5, l31 = lane & 31;
    const bool edge = (J0 < 64) || (J0 + 96 > L);
    const int lm = l31 - 4 * hf;
    LAS unsigned char* kimg = vl; LAS unsigned char* vimg = vl + 8192;
    unsigned voffs[4];
    { const int q_ = lane >> 4;
#pragma unroll
      for (int k = 0; k < 4; ++k) voffs[k] = 2u * (unsigned)(q_ * dd * PW + 8 * ((lane & 15) ^ ((q_ << 2) | k))); }
    bf16x8 qf[8];
    ATT_DMA_FAST(J0, C_Q, kimg);
    asm volatile("s_waitcnt vmcnt(0)" ::: "memory");
    ATT_ROWFRAGS(qf, kimg);
    asm volatile("s_waitcnt lgkmcnt(0)" ::: "memory");
    const int kb0 = __builtin_amdgcn_readfirstlane((5 - rot) % 5);
    ATT_DMA_ANY(J0 - 64 + 32 * kb0, C_K, kimg); ATT_DMA_ANY(J0 - 64 + 32 * kb0, C_V, vimg);
    f32x16 O[4];
#pragma unroll
    for (int db = 0; db < 4; ++db)
#pragma unroll
        for (int i = 0; i < 16; ++i) O[db][i] = 0.f;
    float mrun = -1e30f, lsum = 0.f;
    unsigned tb[2][4];
    { const int blk = (lane >> 4) & 1, q4 = (lane & 15) >> 2, p4 = lane & 3;
#pragma unroll
      for (int t = 0; t < 2; ++t)
#pragma unroll
          for (int db = 0; db < 4; ++db) tb[t][db] = 256u * (4 * hf + q4 + 8 * t) + 64u * (db ^ q4) + 16u * ((2 * blk + (p4 >> 1)) ^ (hf + 2 * t)) + 8u * (p4 & 1); }
#pragma unroll 1
    for (int t = 0; t < 5; ++t) {
        const int kb = __builtin_amdgcn_readfirstlane((t + 5 - rot) % 5), kbn = __builtin_amdgcn_readfirstlane((t + 6 - rot) % 5);
        asm volatile("s_waitcnt vmcnt(8)" ::: "memory");
        f32x16 S;
#pragma unroll
        for (int i = 0; i < 16; ++i) S[i] = 0.f;
#pragma unroll
        for (int kk = 0; kk < 8; ++kk) { const bf16x8 kfr = *(const LAS bf16x8*)(kimg + voff_b(l31, 2 * kk + hf)); S = __builtin_amdgcn_mfma_f32_32x32x16_bf16(kfr, qf[kk], S, 0, 0, 0); }
        asm volatile("s_waitcnt lgkmcnt(0)" ::: "memory");
        if (t < 4) ATT_DMA_ANY(J0 - 64 + 32 * kbn, C_K, kimg);
        if (t < 4) { ATT_SOFTMAX_PV(kb, vimg, asm volatile("s_waitcnt vmcnt(8)" ::: "memory")); }
        else       { ATT_SOFTMAX_PV(kb, vimg, asm volatile("s_waitcnt vmcnt(0)" ::: "memory")); }
        asm volatile("s_waitcnt lgkmcnt(0)" ::: "memory");
        if (t < 4) ATT_DMA_ANY(J0 - 64 + 32 * kbn, C_V, vimg);
    }
    const float ltot = lsum + __shfl_xor(lsum, 32);
    const float inv = 1.0f / ltot;
    const int ql = r + dd * (J0 + l31) - P0;
    bf16* op = Oscr + (size_t)ql * 128 + 4 * hf;
#pragma unroll
    for (int db = 0; db < 4; ++db)
#pragma unroll
        for (int g4 = 0; g4 < 4; ++g4) { v2u w; w.x = cvtpk(O[db][4 * g4 + 0] * inv, O[db][4 * g4 + 1] * inv); w.y = cvtpk(O[db][4 * g4 + 2] * inv, O[db][4 * g4 + 3] * inv);
            *(v2u*)(op + 32 * db + 8 * g4) = w; }
    if (hf == 0) lse_scr[ql] = mrun + __builtin_amdgcn_logf(ltot);
}

__device__ __forceinline__ void attn_item(const Args& a, int h, int blk512, LAS unsigned char* lds, int tid_in, int wave, int lane_in) {
    int tid = tid_in; asm volatile("" : "+v"(tid)); int lane = tid & 63; (void)lane_in;
    unsigned char* ws = a.ws; const bf16* PROJ = (const bf16*)(ws + WS_R1); bf16* MG = (bf16*)(ws + WS_H);
    bf16* Oscr = (bf16*)(ws + WS_MIX) + (size_t)blockIdx.x * (3 * 512 * 128);
    float* lse = (float*)(ws + WS_LSE) + (size_t)blockIdx.x * (3 * 512);
    const int row0 = blk512 * 512;
    const int seq_base = row0 < T_P ? 0 : T_P, S = row0 < T_P ? T_P : T_S, P0 = row0 - seq_base;
    LAS unsigned char* vl = lds + wave * 16384;
#pragma unroll 1
    for (int p = 0; p < 3; ++p) {
        const int dd = p == 0 ? 1 : (p == 1 ? 4 : 16), tpr = 16 / dd, L = S / dd;
#pragma unroll 1
        for (int tt = 0; tt < 2; ++tt) {
            const int tau = wave + 8 * tt, r = tau / tpr, w = tau % tpr;
            attn_wave_tile(PROJ, seq_base, L, dd, r, P0 / dd + 32 * w, h, vl, Oscr + (size_t)p * 512 * 128, lse + p * 512, P0, lane, w % 5);
        }
    }
    __syncthreads();
    asm volatile("" : "+v"(lane));
    float* ssB = (float*)(ws + WS_SSB) + (size_t)h * T;
#pragma unroll 4
    for (int st = 0; st < 16; ++st) {
        const int pl = st * 32 + wave * 4 + (lane >> 4), ch = lane & 15;
        const float l0 = lse[pl], l1 = lse[512 + pl], l2 = lse[1024 + pl];
        const float mx = fmaxf(l0, fmaxf(l1, l2));
        float w0 = __builtin_amdgcn_exp2f(l0 - mx), w1 = __builtin_amdgcn_exp2f(l1 - mx), w2 = __builtin_amdgcn_exp2f(l2 - mx);
        const float iw = 1.0f / (w0 + w1 + w2); w0 *= iw; w1 *= iw; w2 *= iw;
        const v4u a0 = *(const v4u*)(Oscr + (size_t)pl * 128 + 8 * ch), a1 = *(const v4u*)(Oscr + (size_t)(512 + pl) * 128 + 8 * ch), a2 = *(const v4u*)(Oscr + (size_t)(1024 + pl) * 128 + 8 * ch);
        float o[8];
        o[0] = w0 * bflo(a0.x) + w1 * bflo(a1.x) + w2 * bflo(a2.x); o[1] = w0 * bfhi(a0.x) + w1 * bfhi(a1.x) + w2 * bfhi(a2.x);
        o[2] = w0 * bflo(a0.y) + w1 * bflo(a1.y) + w2 * bflo(a2.y); o[3] = w0 * bfhi(a0.y) + w1 * bfhi(a1.y) + w2 * bfhi(a2.y);
        o[4] = w0 * bflo(a0.z) + w1 * bflo(a1.z) + w2 * bflo(a2.z); o[5] = w0 * bfhi(a0.z) + w1 * bfhi(a1.z) + w2 * bfhi(a2.z);
        o[6] = w0 * bflo(a0.w) + w1 * bflo(a1.w) + w2 * bflo(a2.w); o[7] = w0 * bfhi(a0.w) + w1 * bfhi(a1.w) + w2 * bfhi(a2.w);
        float ss = 0.f;
#pragma unroll
        for (int i = 0; i < 8; ++i) ss += o[i] * o[i];
        ss += __shfl_xor(ss, 1); ss += __shfl_xor(ss, 2); ss += __shfl_xor(ss, 4); ss += __shfl_xor(ss, 8);
        v4u ow; ow.x = cvtpk(o[0], o[1]); ow.y = cvtpk(o[2], o[3]); ow.z = cvtpk(o[4], o[5]); ow.w = cvtpk(o[6], o[7]);
        *(v4u*)(MG + (size_t)(row0 + pl) * D + 1024 + h * 128 + 8 * ch) = ow;
        if (ch == 0) ssB[row0 + pl] = ss;
    }
    __syncthreads();
}

#define XB_TMO      128
#define XB_XCNT(j)  (256  + 64 * (j))
#define XB_XSUB(j)  (1280 + 64 * (j))
#define XB_XGEN(j)  (2304 + 64 * (j))
#define XB_TOP      3328
#define XB_TOPGEN   3392
#define XCD_BAR_WORDS 3456
#define XB_SPIN_CAP (1u << 18)

__device__ __forceinline__ unsigned xb_ld(unsigned* p)              { return __hip_atomic_load(p, __ATOMIC_RELAXED, __HIP_MEMORY_SCOPE_AGENT); }
__device__ __forceinline__ unsigned xb_add(unsigned* p, unsigned v) { return __hip_atomic_fetch_add(p, v, __ATOMIC_RELAXED, __HIP_MEMORY_SCOPE_AGENT); }
__device__ __forceinline__ unsigned xb_xcc_id() { return (unsigned)__builtin_amdgcn_s_getreg((3 << 11) | 20) & 0xFu; }
#define XB_SPIN(cond, bar) do { unsigned _sp = 0; while (cond) { __builtin_amdgcn_s_sleep(1); \
    if ((++_sp & 255u) == 0u) { if (xb_ld(&(bar)[XB_TMO])) break; if (_sp > XB_SPIN_CAP) { atomicAdd(&(bar)[XB_TMO], 1u); break; } } } } while (0)

struct XcdBarrier {
    unsigned* bar; unsigned x;
    volatile LAS unsigned* st;
};

__device__ __forceinline__ XcdBarrier xcd_barrier_post(unsigned* bar, volatile LAS unsigned* st, int wave_s) {
    XcdBarrier b; b.bar = bar; b.x = xb_xcc_id(); b.st = st;
    if (wave_s == 0 && fresh_lane() == 0) (void)xb_add(&bar[XB_XCNT(b.x)], 1u);
    return b;
}
__device__ __forceinline__ void xcd_barrier_complete(unsigned* bar, unsigned x, unsigned& nloc, unsigned& nx) {
    const unsigned G = gridDim.x * gridDim.y * gridDim.z;
    unsigned sum, cnt, mine, sp = 0u;
    for (;;) {
        sum = 0u; cnt = 0u; mine = 0u;
#pragma unroll
        for (unsigned j = 0; j < 16; ++j) { const unsigned c = xb_ld(&bar[XB_XCNT(j)]); sum += c; cnt += (c > 0u) ? 1u : 0u; mine = (j == x) ? c : mine; }
        if (sum == G) break;
        __builtin_amdgcn_s_sleep(1);
        if ((++sp & 255u) == 0u) { if (xb_ld(&bar[XB_TMO])) break; if (sp > XB_SPIN_CAP) { atomicAdd(&bar[XB_TMO], 1u); break; } }
    }
    nloc = mine > 0u ? mine : 1u; nx = cnt > 0u ? cnt : 1u;
}

__device__ __forceinline__ void xcd_barrier(const XcdBarrier& b, int wave_s) {
    asm volatile("s_waitcnt vmcnt(0)" ::: "memory");
    __syncthreads();
    if (wave_s == 0 && fresh_lane() == 0) {
        unsigned* bar = b.bar;
        __builtin_amdgcn_s_waitcnt(0);
        unsigned nloc = b.st[0], nx = b.st[1];
        if (nloc == 0u) { xcd_barrier_complete(bar, b.x, nloc, nx); b.st[0] = nloc; b.st[1] = nx; }
        const unsigned old = xb_add(&bar[XB_XSUB(b.x)], 1u);
        const unsigned gen = old / nloc;
        if (old + 1u == (gen + 1u) * nloc) {
            __builtin_amdgcn_fence(__ATOMIC_RELEASE, "agent");
            asm volatile("s_waitcnt vmcnt(0)" ::: "memory");
            const unsigned og = xb_add(&bar[XB_TOP], 1u);
            const unsigned tg = og / nx;
            if (og + 1u == (tg + 1u) * nx) xb_add(&bar[XB_TOPGEN], 1u);
            else XB_SPIN(xb_ld(&bar[XB_TOPGEN]) == tg, bar);
            __builtin_amdgcn_fence(__ATOMIC_ACQUIRE, "agent");
            xb_add(&bar[XB_XGEN(b.x)], 1u);
            asm volatile("s_waitcnt vmcnt(0)" ::: "memory");
        } else {
            XB_SPIN(xb_ld(&bar[XB_XGEN(b.x)]) == gen, bar);
            __builtin_amdgcn_fence(__ATOMIC_ACQUIRE, "agent");
            asm volatile("s_waitcnt vmcnt(0)" ::: "memory");
        }
    }
    __syncthreads();
}

__global__ void __launch_bounds__(NTHREADS, 2) fwd_megakernel(Args a) {
    extern __shared__ __attribute__((aligned(16))) unsigned char lds_raw[];
    LAS unsigned char* lds = (LAS unsigned char*)lds_raw;
    cg::grid_group grid = cg::this_grid();
#define PHASE_IDS() int tid = fresh_tid(wave_s); asm volatile("" : "+v"(tid)); const int lane = tid & 63, wave = __builtin_amdgcn_readfirstlane(tid >> 6); \
    int bid = blockIdx.x; asm volatile("" : "+s"(bid)); const int gw = bid * NWAVES + wave, NGW = G * NWAVES; (void)lane; (void)gw; (void)NGW;
    const int G = gridDim.x;
    const int wave_s = __builtin_amdgcn_readfirstlane(threadIdx.x >> 6);
    unsigned char* ws = a.ws;
    const float* rope = (const float*)(ws + WS_ROPE);
    {
        volatile LAS unsigned* misc0 = (volatile LAS unsigned*)(lds + MISC_OFF);
        if (threadIdx.x < 16) misc0[threadIdx.x] = 0u;
        if (blockIdx.x == 0) for (int i = threadIdx.x; i < 4096; i += NTHREADS) ((unsigned*)(ws + WS_CTL))[i] = 0u;
        __syncthreads();
    }

    for (int rep = 0; rep < REP_PRO; ++rep) { PHASE_IDS(); prologue_phase(a, lds, gw, NGW, wave, lane); }
    { PHASE_IDS(); resnorm_phase<true, false>(a, nullptr, a.in[2], gw, NGW, lane); }
    grid.sync();
    const XcdBarrier bar = xcd_barrier_post((unsigned*)(ws + WS_CTL), (volatile LAS unsigned*)(lds + MISC_OFF), wave_s);

#pragma unroll 1
    for (int l = 0; l < DEPTH; ++l) {
        {
            pg8::Gemm g{(const bf16*)(ws + WS_H), (const bf16*)(ws + WS_WIN) + (size_t)l * PW * D, T, PW, D};
            pg8::StaticOrder S; S.init(T, PW, G, (int)blockIdx.x);
            pg8::EpiProj E{(bf16*)(ws + WS_R1), rope, QSCALE};

            for (int rep = 0; rep < REP_GEMM; ++rep) { pg8::gemm_phase<pg8::EpiProj, pg8::StaticOrder, true, true>(lds, g, S, E, wave_s); }
            if (l + 1 < DEPTH) { PHASE_IDS(); (void)gw; convert_in_idle_slot(a, lds, l + 1, 0, (T / 256) * (PW / 256), G, bid, wave, lane); }
        }
        xcd_barrier(bar, wave_s);
        {
            constexpr int N_ATT = 8 * (T / 512), N_GM = 8 * (T / 128);
            PHASE_IDS(); (void)bid;
            unsigned* qhead = (unsigned*)(ws + WS_CTL) + 3584 + 64 * l;
            volatile LAS int* slot = (volatile LAS int*)(lds + MISC_OFF + 64);
            if (tid == 0) *slot = (int)__hip_atomic_fetch_add(qhead, 1u, __ATOMIC_RELAXED, __HIP_MEMORY_SCOPE_AGENT);
            __syncthreads();
            int it = *slot;
            while (it < N_ATT + N_GM) {
                __syncthreads();
                if (tid == 0) *slot = (int)__hip_atomic_fetch_add(qhead, 1u, __ATOMIC_RELAXED, __HIP_MEMORY_SCOPE_AGENT);
                if (it < N_ATT) attn_item(a, it & 7, it >> 3, lds, tid, wave, lane);
                else { const int j = it - N_ATT; gmlp_item(a, l, j >> 3, j & 7, lds, tid, wave, lane); }
                __syncthreads();
                it = *slot;
            }
        }
        xcd_barrier(bar, wave_s);
        {
            pg8::Gemm g{(const bf16*)(ws + WS_H), (const bf16*)(ws + WS_WO) + (size_t)l * D * D, T, D, D};
            pg8::StaticOrder S; S.init(T, D, G, (int)blockIdx.x);
            pg8::EpiMixKS E{(bf16*)(ws + WS_MIX), (float*)(ws + WS_SSM), (const float*)(ws + WS_SSA), (const float*)(ws + WS_SSB), (LAS float*)(lds + 131072), T};
            for (int rep = 0; rep < REP_GEMM; ++rep) { pg8::gemm_phase<pg8::EpiMixKS, pg8::StaticOrder, true, true>(lds, g, S, E, wave_s); }
        }
        xcd_barrier(bar, wave_s);
        { PHASE_IDS(); resnorm_phase<false, false>(a, a.in[10] + (size_t)l * D, a.in[11] + (size_t)l * D, gw, NGW, lane); }
        xcd_barrier(bar, wave_s);
        {
            pg8::Gemm g{(const bf16*)(ws + WS_H), (const bf16*)(ws + WS_WGU) + (size_t)l * 2 * FF * D, T, 2 * FF, D};
            pg8::StaticOrder S; S.init(T, 2 * FF, G, (int)blockIdx.x);
            pg8::EpiGU E{(bf16*)(ws + WS_R1)};

            for (int rep = 0; rep < REP_GEMM; ++rep) { pg8::gemm_phase<pg8::EpiGU, pg8::StaticOrder, true, true>(lds, g, S, E, wave_s); }
            if (l + 1 < DEPTH) { PHASE_IDS(); (void)gw; convert_in_idle_slot(a, lds, l + 1, 1, (T / 256) * (2 * FF / 256), G, bid, wave, lane); }
        }
        xcd_barrier(bar, wave_s);
        {
            pg8::Gemm g{(const bf16*)(ws + WS_R1), (const bf16*)(ws + WS_WDN) + (size_t)l * D * FF, T, D, FF};
            pg8::StaticOrder S; S.init(T, D, G, (int)blockIdx.x);
            pg8::EpiMix E{(bf16*)(ws + WS_MIX), (float*)(ws + WS_SSM)};

            for (int rep = 0; rep < REP_GEMM; ++rep) { pg8::gemm_phase<pg8::EpiMix, pg8::StaticOrder, true, true>(lds, g, S, E, wave_s); }
        }
        xcd_barrier(bar, wave_s);
        if (l + 1 < DEPTH) { { PHASE_IDS(); resnorm_phase<false, false>(a, a.in[15] + (size_t)l * D, a.in[2] + (size_t)(l + 1) * D, gw, NGW, lane); } xcd_barrier(bar, wave_s); }
        else { PHASE_IDS(); resnorm_phase<false, true>(a, a.in[15] + (size_t)l * D, nullptr, gw, NGW, lane); }
    }
}

extern "C" void kernel_launch(void* const* d_in, const int* in_sizes, int n_in, void* d_out, int out_size, void* d_ws, size_t ws_size, hipStream_t stream) {
    static int grid = 0;
    if (grid == 0) {
        if (n_in != 16 || out_size != T * D || ws_size < WS_END) { fprintf(stderr, "kernel_launch: unexpected shapes (n_in %d, out %d, ws %zu); nothing launched\n", n_in, out_size, ws_size); grid = -1; return; }
        int dev = 0, cus = 0, per_cu = 0;
        hipGetDevice(&dev); hipDeviceGetAttribute(&cus, hipDeviceAttributeMultiprocessorCount, dev);
        if (hipFuncSetAttribute((const void*)fwd_megakernel, hipFuncAttributeMaxDynamicSharedMemorySize, LDS_BYTES) != hipSuccess) { fprintf(stderr, "kernel_launch: hipFuncSetAttribute failed\n"); grid = -1; return; }
        if (hipOccupancyMaxActiveBlocksPerMultiprocessor(&per_cu, (const void*)fwd_megakernel, NTHREADS, LDS_BYTES) != hipSuccess || per_cu < 1) { fprintf(stderr, "kernel_launch: occupancy query says %d\n", per_cu); per_cu = 1; }
        (void)hipGetLastError();
        grid = cus * (per_cu > 1 ? 1 : per_cu);
        if (grid <= 0) grid = 256;
    }
    if (grid < 0) return;
    Args a{};
    for (int i = 0; i < 16; ++i) a.in[i] = (const float*)d_in[i];
    a.out = (float*)d_out; a.ws = (unsigned char*)d_ws;
    void* args[] = {&a};
    hipError_t e = hipLaunchCooperativeKernel((const void*)fwd_megakernel, dim3(grid), dim3(NTHREADS), args, LDS_BYTES, stream);
    if (e != hipSuccess) fprintf(stderr, "kernel_launch: cooperative launch failed: %s (grid %d)\n", hipGetErrorString(e), grid);
}
```
